# Optimizing an MI355X kernel written in HIP

```python
import math
import jax, jax.numpy as jnp
from jax import lax
import numpy as np

D_MODEL = 1024
BATCH = 2
SEQ = 8192
DEPTH = 1

N_HEADS = 8
HEAD_DIM = 64
ATTN_WIDTH = N_HEADS * HEAD_DIM
MOBA_BLOCK = 256
MOBA_TOPK = 3
Q_CHUNK = 64
NUM_BUCKETS = 32
MAX_DISTANCE = 128
POOL_WINDOWS = (2, 4, 8, 16)
POOL_GROUPS = 4
POOL_GROUP_DIM = 128
POOL_WIDTH = POOL_GROUPS * POOL_GROUP_DIM
N_BRANCHES = 2
IN_COLS = 3 * ATTN_WIDTH + POOL_WIDTH + N_BRANCHES * D_MODEL
N_EXPERTS = 32
TOP_K = 4
D_EXPERT = D_MODEL
SWIGLU_LIMIT = 7.0
SWIGLU_ALPHA = 1.702
EXPERT_BLOCK = 128
PLE_DIM = 256
RMS_EPS = 1e-6

kernel_name = "hybrid_moba_pool_moe_block"


def rms_norm(x, g):
    xf = x.astype(jnp.float32)
    y = xf * lax.rsqrt(jnp.mean(xf * xf, axis=-1, keepdims=True) + RMS_EPS)
    return (y * g.astype(jnp.float32)).astype(x.dtype)


def t5_causal_bucket(rel):
    n = jnp.maximum(rel, 0)
    max_exact = NUM_BUCKETS // 2
    nf = jnp.maximum(n, 1).astype(jnp.float32)
    large = max_exact + (jnp.log(nf / max_exact) / math.log(MAX_DISTANCE / max_exact)
                         * (NUM_BUCKETS - max_exact)).astype(jnp.int32)
    large = jnp.minimum(large, NUM_BUCKETS - 1)
    return jnp.where(n < max_exact, n, large)


def moba_attention(q, k, v, rel_bias):
    b, h, s, dh = q.shape
    nb = -(-s // MOBA_BLOCK)
    s_pad = nb * MOBA_BLOCK
    k_eff = min(MOBA_TOPK, nb)
    pad = ((0, 0), (0, 0), (0, s_pad - s), (0, 0))
    k = jnp.pad(k, pad)
    v = jnp.pad(v, pad)
    k_blocks = k.reshape(b, h, nb, MOBA_BLOCK, dh)
    v_blocks = v.reshape(b, h, nb, MOBA_BLOCK, dh)
    k_mean = jnp.mean(k_blocks.astype(jnp.float32), axis=3)
    bias_t = rel_bias.astype(jnp.float32).T
    b_idx = jnp.arange(b)[:, None, None, None]
    h_idx = jnp.arange(h)[None, :, None, None]
    scale = dh ** -0.5
    neg = jnp.finfo(jnp.float32).min
    in_block = jnp.arange(MOBA_BLOCK)
    n_sel = k_eff * MOBA_BLOCK

    def chunk(c):
        q0 = c * Q_CHUNK
        j = q0 // MOBA_BLOCK
        qc = lax.dynamic_slice_in_dim(q, q0, Q_CHUNK, axis=2).astype(jnp.float32) * scale
        qpos = q0 + jnp.arange(Q_CHUNK)
        gate = jnp.einsum('bhqd,bhnd->bhqn', qc, k_mean)
        gate = jnp.where(jnp.arange(nb) < j, gate, neg)
        _, sel = lax.top_k(gate, k_eff)
        valid = jnp.arange(k_eff) < j
        k_sel = k_blocks[b_idx, h_idx, sel].astype(jnp.float32)
        v_sel = v_blocks[b_idx, h_idx, sel].astype(jnp.float32)
        s_sel = jnp.einsum('bhqd,bhqnkd->bhqnk', qc, k_sel)
        rel_sel = qpos[:, None, None] - (sel[..., None] * MOBA_BLOCK + in_block)
        s_sel = s_sel + bias_t[h_idx[..., None], t5_causal_bucket(rel_sel)]
        s_sel = jnp.where(valid[:, None], s_sel, neg)
        k_own = lax.dynamic_slice_in_dim(k, j * MOBA_BLOCK, MOBA_BLOCK, axis=2).astype(jnp.float32)
        v_own = lax.dynamic_slice_in_dim(v, j * MOBA_BLOCK, MOBA_BLOCK, axis=2).astype(jnp.float32)
        rel_own = qpos[:, None] - (j * MOBA_BLOCK + in_block)[None, :]
        s_own = jnp.einsum('bhqd,bhkd->bhqk', qc, k_own) + bias_t[:, t5_causal_bucket(rel_own)]
        s_own = jnp.where(rel_own >= 0, s_own, neg)
        logits = jnp.concatenate([s_sel.reshape(b, h, Q_CHUNK, n_sel), s_own], axis=-1)
        probs = jax.nn.softmax(logits, axis=-1)
        p_sel = probs[..., :n_sel].reshape(b, h, Q_CHUNK, k_eff, MOBA_BLOCK)
        p_own = probs[..., n_sel:]
        return (jnp.einsum('bhqnk,bhqnkd->bhqd', p_sel, v_sel)
                + jnp.einsum('bhqk,bhkd->bhqd', p_own, v_own))

    out = lax.map(chunk, jnp.arange(s // Q_CHUNK))
    out = out.transpose(1, 0, 3, 2, 4).reshape(b, s, h * dh)
    return out.astype(q.dtype)


def causal_multiscale_pool(u):
    b, s, _ = u.shape
    ug = u.astype(jnp.float32).reshape(b, s, POOL_GROUPS, POOL_GROUP_DIM)
    csum = jnp.concatenate([jnp.zeros((b, 1, POOL_GROUPS, POOL_GROUP_DIM), jnp.float32),
                            jnp.cumsum(ug, axis=1)], axis=1)
    t = jnp.arange(s)
    w = jnp.array(POOL_WINDOWS, dtype=jnp.int32)
    lo = jnp.maximum(t[:, None] + 1 - w[None, :], 0)
    cnt = jnp.minimum(t[:, None] + 1, w[None, :]).astype(jnp.float32)
    g_idx = jnp.arange(POOL_GROUPS)[None, :]
    window_sum = csum[:, 1:] - csum[:, lo, g_idx]
    return window_sum / cnt[None, :, :, None] - ug


def moe_ffn(hf, router_w, router_b, w_gate_up, b_gate_up, w_down, b_down):
    t, d = hf.shape
    logits = (hf @ router_w + router_b).astype(jnp.float32)
    top_vals, top_idx = lax.top_k(logits, TOP_K)
    gates = jax.nn.softmax(top_vals, axis=-1).astype(hf.dtype)
    n_assign = t * TOP_K
    flat_e = top_idx.reshape(-1)
    flat_tok = jnp.arange(n_assign, dtype=jnp.int32) // TOP_K
    flat_w = gates.reshape(-1)
    order = jnp.argsort(flat_e)
    sorted_e = flat_e[order]
    counts = jnp.bincount(flat_e, length=N_EXPERTS)
    starts = jnp.cumsum(counts) - counts
    padded = (counts + EXPERT_BLOCK - 1) // EXPERT_BLOCK * EXPERT_BLOCK
    pend = jnp.cumsum(padded)
    pstart = pend - padded
    dest = pstart[sorted_e] + jnp.arange(n_assign) - starts[sorted_e]
    n_pad = n_assign + N_EXPERTS * EXPERT_BLOCK
    n_blk = n_pad // EXPERT_BLOCK
    row_tok = jnp.zeros((n_pad,), jnp.int32).at[dest].set(flat_tok[order])
    row_w = jnp.zeros((n_pad,), hf.dtype).at[dest].set(flat_w[order])
    blk_expert = jnp.minimum(
        jnp.searchsorted(pend, jnp.arange(n_blk) * EXPERT_BLOCK, side='right'), N_EXPERTS - 1)

    def run_block(args):
        tok, wt, e = args
        xb = hf[tok]
        gu = xb @ w_gate_up[e] + b_gate_up[e]
        glu_in = jnp.minimum(gu[:, 0::2], SWIGLU_LIMIT)
        lin = jnp.clip(gu[:, 1::2], -SWIGLU_LIMIT, SWIGLU_LIMIT)
        hid = (lin + 1) * (glu_in * jax.nn.sigmoid(SWIGLU_ALPHA * glu_in))
        y = hid @ w_down[e] + b_down[e]
        return y * wt[:, None]

    ys = lax.map(run_block, (row_tok.reshape(n_blk, EXPERT_BLOCK),
                             row_w.reshape(n_blk, EXPERT_BLOCK), blk_expert))
    return jax.ops.segment_sum(ys.reshape(n_pad, d), row_tok, num_segments=t)


def setup_inputs(seed: int = 0) -> dict:
    key = jax.random.key(seed)
    ks = jax.random.split(key, 24)

    def nrm(k, shape, scale):
        return jax.random.normal(k, shape, jnp.float32) * scale

    D, E, F = D_MODEL, N_EXPERTS, D_EXPERT
    return {
        "x": nrm(ks[0], (BATCH, SEQ, D), 1.0),
        "p": nrm(ks[1], (DEPTH, BATCH, SEQ, PLE_DIM), 1.0),
        "rel_bias": nrm(ks[2], (NUM_BUCKETS, N_HEADS), 0.5),
        "norm_mix_g": 1.0 + nrm(ks[3], (DEPTH, D), 0.05),
        "w_in": nrm(ks[4], (DEPTH, D, IN_COLS), D ** -0.5),
        "pool_w": nrm(ks[5], (DEPTH, POOL_GROUPS, POOL_GROUP_DIM, POOL_GROUP_DIM), POOL_GROUP_DIM ** -0.5),
        "pool_scale": 1.0 + nrm(ks[6], (DEPTH, POOL_WIDTH), 0.1),
        "w_o_attn": nrm(ks[7], (DEPTH, ATTN_WIDTH, D), ATTN_WIDTH ** -0.5),
        "w_o_pool": nrm(ks[8], (DEPTH, POOL_WIDTH, D), POOL_WIDTH ** -0.5),
        "w_out": nrm(ks[9], (DEPTH, D, D), D ** -0.5),
        "norm_ffn_g": 1.0 + nrm(ks[10], (DEPTH, D), 0.05),
        "router_w": nrm(ks[11], (DEPTH, D, E), D ** -0.5),
        "router_b": nrm(ks[12], (DEPTH, E), 0.01),
        "w_gate_up": nrm(ks[13], (DEPTH, E, D, 2 * F), D ** -0.5),
        "b_gate_up": nrm(ks[14], (DEPTH, E, 2 * F), 0.02),
        "w_down": nrm(ks[15], (DEPTH, E, F, D), F ** -0.5),
        "b_down": nrm(ks[16], (DEPTH, E, D), 0.02),
        "norm_ple_g": 1.0 + nrm(ks[17], (DEPTH, D), 0.05),
        "w_ple_gate": nrm(ks[18], (DEPTH, D, D), D ** -0.5),
        "w_ple_proj": nrm(ks[19], (DEPTH, PLE_DIM, D), PLE_DIM ** -0.5),
        "norm_final_g": 1.0 + nrm(ks[20], (D,), 0.05),
    }


def reference(x, p, rel_bias, norm_mix_g, w_in, pool_w, pool_scale, w_o_attn, w_o_pool, w_out,
              norm_ffn_g, router_w, router_b, w_gate_up, b_gate_up, w_down, b_down,
              norm_ple_g, w_ple_gate, w_ple_proj, norm_final_g):
    b, s, d = x.shape
    cuts = [ATTN_WIDTH, 2 * ATTN_WIDTH, 3 * ATTN_WIDTH, 3 * ATTN_WIDTH + POOL_WIDTH]

    def heads(t):
        return t.reshape(b, s, N_HEADS, HEAD_DIM).transpose(0, 2, 1, 3)

    for i in range(DEPTH):
        h = rms_norm(x, norm_mix_g[i])
        q, k, v, u, g = jnp.split(h @ w_in[i], cuts, axis=-1)
        attn = moba_attention(heads(q), heads(k), heads(v), rel_bias)
        pooled = jnp.einsum('bsgc,gcd->bsgd', causal_multiscale_pool(u),
                            pool_w[i].astype(jnp.float32)).reshape(b, s, POOL_WIDTH)
        pooled = (pooled * pool_scale[i].astype(jnp.float32)).astype(x.dtype)
        gates = jax.nn.sigmoid(g.reshape(b, s, N_BRANCHES, d))
        merged = gates[:, :, 0] * (attn @ w_o_attn[i]) + gates[:, :, 1] * (pooled @ w_o_pool[i])
        x = x + merged @ w_out[i]
        hf = rms_norm(x, norm_ffn_g[i]).reshape(b * s, d)
        x = x + moe_ffn(hf, router_w[i], router_b[i], w_gate_up[i], b_gate_up[i],
                        w_down[i], b_down[i]).reshape(b, s, d)
        hp = rms_norm(x, norm_ple_g[i])
        x = x + jax.nn.sigmoid(hp @ w_ple_gate[i]) * (p[i] @ w_ple_proj[i])
    return rms_norm(x, norm_final_g)
```

```cpp
#include <hip/hip_runtime.h>
#include <cstdio>
#include <cstdint>
namespace pg8 {
#define PG8_LAS __attribute__((address_space(3)))
typedef unsigned short bf16_t;
typedef short bf16x8 __attribute__((ext_vector_type(8)));
typedef float f32x4 __attribute__((ext_vector_type(4)));
typedef unsigned u32x4 __attribute__((ext_vector_type(4)));
constexpr int BM = 256, BK = 64, HALF = 128, HTB = HALF * BK * 2  , STAGE_BYTES = 8 * HTB, NXCD = 8, WGM = 8;

__host__ __device__ __forceinline__ int lds_byte(int r, int c) { const int st = (r >> 4) * 2 + (c >> 5), rr = r & 15, cc = c & 31, ob = rr * 64 + cc * 2; return st * 1024 + (ob ^ (((ob >> 9) & 1) << 5)); }
__host__ __device__ __forceinline__ void stage_rc(int b, int& R, int& C) { const int st = b / 1024, sb = b % 1024, swz = sb ^ (((sb >> 9) & 1) << 5); R = (st >> 1) * 16 + swz / 64; C = (st & 1) * 32 + (swz % 64) / 2; }
__host__ __device__ __forceinline__ int perm32(int rho) { const int n = rho >> 4, i = rho & 15; return 8 * (i >> 2) + 4 * n + (i & 3); }

struct Unit { int pm, pn; };
struct Gemm { const bf16_t* A; const bf16_t* Bt; int M, N, K; };

struct StaticOrder {
    int nM, nN, nwg, G, c;
    __host__ __device__ void init(int M, int N, int G_, int c_) { nM = M / BM; nN = N / BM; nwg = nM * nN; G = G_; c = c_; }
    __host__ __device__ bool next(int i, Unit& u) const {
        const long L = (long)i * G + c; if (L >= nwg) return false;
        int wgid = (int)L; { const int q = nwg / NXCD, r = nwg % NXCD, xcd = wgid % NXCD, off = wgid / NXCD; wgid = (xcd < r ? xcd * (q + 1) : r * (q + 1) + (xcd - r) * q) + off; }
        const int nig = WGM * nN, gid = wgid / nig, fm = gid * WGM, gsz = (nM - fm) < WGM ? (nM - fm) : WGM;
        u.pm = fm + ((wgid % nig) % gsz); u.pn = (wgid % nig) / gsz; return true;
    }
    __device__ __forceinline__ void a_ready(const Unit&) const {}
    __device__ __forceinline__ void done(const Unit&) const {}
};
__device__ __forceinline__ unsigned cvt_pk_bf16(float lo, float hi) { unsigned r; asm volatile("v_cvt_pk_bf16_f32 %0, %1, %2" : "=v"(r) : "v"(lo), "v"(hi)); return r; }
template <class Epi, class Sched, bool ALIGN_EPI = false, bool SP2 = false>
__device__ __forceinline__ void gemm_phase(PG8_LAS unsigned char* lds, const Gemm g, const Sched& S, const Epi& E) {
    const int tid = threadIdx.x, wid = __builtin_amdgcn_readfirstlane(tid >> 6), lane = tid & 63, wr = wid >> 2, wc = wid & 3, fr = lane & 15, fq = lane >> 4;
    int K_ = g.K; asm volatile("" : "+s"(K_)); const int K = K_, nt = K / BK;
    unsigned voffA[2], voffB[2];
#pragma unroll
    for (int i = 0; i < 2; ++i) { int R, C; stage_rc(tid * 16 + i * 8192, R, C); const int Rb = Epi::PERM ? ((R & ~31) + perm32(R & 31)) : R;
        voffA[i] = (unsigned)(R * K + C) * 2u; voffB[i] = (unsigned)(Rb * K + C) * 2u; }
    const size_t kstep = (size_t)(BK * 2);
    const size_t hstep = (size_t)HALF * K * 2;
    const size_t tstep = 2 * hstep;
    const unsigned ldsw = (unsigned)wid * 1024u;
    const int aoff = lds_byte(wr * 64 + fr, fq * 8), boff = lds_byte(wc * 32 + fr, fq * 8);
#define PG8_SA(b, h) (((b) * 2 + (h)) * HTB)
#define PG8_SB(b, h) ((4 + (b) * 2 + (h)) * HTB)
#define PG8_STAGE(bufoff, gbase, voff) do { _Pragma("unroll") for (int _i = 0; _i < 2; ++_i) \
        __builtin_amdgcn_global_load_lds((const unsigned*)((const char*)(gbase) + (voff)[_i]), (PG8_LAS unsigned*)(lds + (bufoff) + ldsw + _i * 8192), 16, 0, 0); } while (0)
#define PG8_LDA(dst, b, h) do { _Pragma("unroll") for (int m = 0; m < 4; ++m) _Pragma("unroll") for (int k = 0; k < 2; ++k) dst[m][k] = *(const PG8_LAS bf16x8*)(lds + PG8_SA(b, h) + aoff + m * 2048 + k * 1024); } while (0)
#define PG8_LDB(dst, b, h) do { _Pragma("unroll") for (int n = 0; n < 2; ++n) _Pragma("unroll") for (int k = 0; k < 2; ++k) dst[n][k] = *(const PG8_LAS bf16x8*)(lds + PG8_SB(b, h) + boff + n * 2048 + k * 1024); } while (0)
#define PG8_MMA(ai, bj, At, Bt) do { __builtin_amdgcn_s_setprio(1); _Pragma("unroll") for (int m = 0; m < 4; ++m) _Pragma("unroll") for (int n = 0; n < 2; ++n) _Pragma("unroll") for (int k = 0; k < 2; ++k) \
        acc[ai][bj][m][n] = __builtin_amdgcn_mfma_f32_16x16x32_bf16(Bt[n][k], At[m][k], acc[ai][bj][m][n], 0, 0, 0); __builtin_amdgcn_s_setprio(0); } while (0)
#define PG8_WAIT_V(n) asm volatile("s_waitcnt vmcnt(" #n ")" ::: "memory")
#define PG8_WAIT_L(n) asm volatile("s_waitcnt lgkmcnt(" #n ")" ::: "memory")
#define PG8_BAR __builtin_amdgcn_s_barrier()
#define PG8_SCHED __builtin_amdgcn_sched_barrier(0)
    Unit cur, nxt; int ui = 0;
    if (!S.next(0, cur)) return;
    f32x4 acc[2][2][4][2];
#pragma unroll
    for (int a = 0; a < 2; ++a)
#pragma unroll
        for (int b = 0; b < 2; ++b)
#pragma unroll
            for (int m = 0; m < 4; ++m)
#pragma unroll
                for (int n = 0; n < 2; ++n) acc[a][b][m][n] = (f32x4){0.f, 0.f, 0.f, 0.f};
    bf16x8 At[4][2], B0[2][2], B1[2][2];
    const char* cA = (const char*)g.A + (size_t)cur.pm * tstep; const char* cB = (const char*)g.Bt + (size_t)cur.pn * tstep;
    S.a_ready(cur);
    if constexpr (SP2) {
        PG8_STAGE(PG8_SB(0, 0), cB, voffB); PG8_STAGE(PG8_SB(0, 1), cB + hstep, voffB); PG8_STAGE(PG8_SA(0, 0), cA, voffA); PG8_STAGE(PG8_SA(0, 1), cA + hstep, voffA);
        if (wr == 1) PG8_BAR;
        PG8_WAIT_V(2); PG8_BAR;
        PG8_STAGE(PG8_SB(1, 0), cB + kstep, voffB); PG8_STAGE(PG8_SA(1, 0), cA + kstep, voffA); PG8_STAGE(PG8_SB(1, 1), cB + hstep + kstep, voffB);
        PG8_WAIT_V(6); PG8_BAR;
    } else {
        PG8_STAGE(PG8_SB(0, 0), cB, voffB); PG8_STAGE(PG8_SA(0, 0), cA, voffA); PG8_STAGE(PG8_SB(0, 1), cB + hstep, voffB); PG8_STAGE(PG8_SA(0, 1), cA + hstep, voffA);
        if (wr == 1) PG8_BAR;
        PG8_WAIT_V(4); PG8_BAR;
        PG8_STAGE(PG8_SB(1, 0), cB + kstep, voffB); PG8_STAGE(PG8_SA(1, 0), cA + kstep, voffA); PG8_STAGE(PG8_SB(1, 1), cB + hstep + kstep, voffB);
        PG8_WAIT_V(6); PG8_BAR;
    }
    for (;;) {
        const bool has_next = S.next(ui + 1, nxt);
        const char* nA = has_next ? (const char*)g.A + (size_t)nxt.pm * tstep : cA; const char* nB = has_next ? (const char*)g.Bt + (size_t)nxt.pn * tstep : cB;
        for (int t = 0; t < nt; t += 2) {
            const bool last = (t == nt - 2);
            const char* a1 = cA + (size_t)(t + 1) * kstep;
            const char* a2 = last ? nA : cA + (size_t)(t + 2) * kstep; const char* b2 = last ? nB : cB + (size_t)(t + 2) * kstep;
            const char* a3 = a2 + kstep; const char* b3 = b2 + kstep;
            if (last && has_next) S.a_ready(nxt);
            if constexpr (SP2) {
            PG8_LDB(B0, 0, 0); PG8_LDB(B1, 0, 1); PG8_SCHED; PG8_LDA(At, 0, 0); PG8_STAGE(PG8_SA(1, 1), a1 + hstep, voffA);
            PG8_WAIT_V(8); PG8_WAIT_L(0); PG8_BAR; PG8_MMA(0, 0, At, B0); PG8_MMA(0, 1, At, B1); PG8_BAR; PG8_SCHED;
            PG8_LDA(At, 0, 1); PG8_STAGE(PG8_SB(0, 0), b2, voffB); PG8_STAGE(PG8_SB(0, 1), b2 + hstep, voffB); PG8_STAGE(PG8_SA(0, 0), a2, voffA);
            PG8_WAIT_V(8); PG8_WAIT_L(0); PG8_BAR; PG8_MMA(1, 0, At, B0); PG8_MMA(1, 1, At, B1); PG8_BAR; PG8_SCHED;
            PG8_LDB(B0, 1, 0); PG8_LDB(B1, 1, 1); PG8_SCHED; PG8_LDA(At, 1, 0); PG8_STAGE(PG8_SA(0, 1), a2 + hstep, voffA);
            PG8_WAIT_V(8); PG8_WAIT_L(0); PG8_BAR; PG8_MMA(0, 0, At, B0); PG8_MMA(0, 1, At, B1); PG8_BAR; PG8_SCHED;
            PG8_LDA(At, 1, 1); PG8_STAGE(PG8_SB(1, 0), b3, voffB); PG8_STAGE(PG8_SB(1, 1), b3 + hstep, voffB); PG8_STAGE(PG8_SA(1, 0), a3, voffA);
            PG8_WAIT_V(8); PG8_WAIT_L(0); PG8_BAR; PG8_MMA(1, 0, At, B0); PG8_MMA(1, 1, At, B1); PG8_BAR; PG8_SCHED;
            } else {
            PG8_LDB(B0, 0, 0); PG8_SCHED; PG8_LDA(At, 0, 0); PG8_STAGE(PG8_SA(1, 1), a1 + hstep, voffA);
            PG8_WAIT_L(8); PG8_BAR; PG8_WAIT_L(0); PG8_MMA(0, 0, At, B0); PG8_BAR; PG8_SCHED;
            PG8_LDB(B1, 0, 1); PG8_STAGE(PG8_SB(0, 0), b2, voffB);
            PG8_BAR; PG8_WAIT_L(0); PG8_MMA(0, 1, At, B1); PG8_BAR;
            PG8_LDA(At, 0, 1); PG8_STAGE(PG8_SA(0, 0), a2, voffA);
            PG8_BAR; PG8_WAIT_L(0); PG8_MMA(1, 0, At, B0); PG8_BAR; PG8_SCHED;
            PG8_STAGE(PG8_SB(0, 1), b2 + hstep, voffB);
            PG8_WAIT_V(6); PG8_BAR; PG8_MMA(1, 1, At, B1); PG8_BAR;
            PG8_LDB(B0, 1, 0); PG8_SCHED; PG8_LDA(At, 1, 0); PG8_STAGE(PG8_SA(0, 1), a2 + hstep, voffA);
            PG8_WAIT_L(8); PG8_BAR; PG8_WAIT_L(0); PG8_MMA(0, 0, At, B0); PG8_BAR; PG8_SCHED;
            PG8_LDB(B1, 1, 1); PG8_STAGE(PG8_SB(1, 0), b3, voffB);
            PG8_BAR; PG8_WAIT_L(0); PG8_MMA(0, 1, At, B1); PG8_BAR;
            PG8_LDA(At, 1, 1); PG8_STAGE(PG8_SA(1, 0), a3, voffA);
            PG8_BAR; PG8_WAIT_L(0); PG8_MMA(1, 0, At, B0); PG8_BAR; PG8_SCHED;
            PG8_STAGE(PG8_SB(1, 1), b3 + hstep, voffB);
            PG8_WAIT_V(6); PG8_BAR; PG8_MMA(1, 1, At, B1); PG8_BAR;
            }
        }
        if constexpr (ALIGN_EPI) { if (wr == 0) PG8_BAR; }
        if constexpr (!Epi::AFTER_DRAIN) { E(acc, cur, wr, wc, fr, fq); S.done(cur); }
        if (!has_next) break;
#pragma unroll
        for (int a = 0; a < 2; ++a)
#pragma unroll
            for (int b = 0; b < 2; ++b)
#pragma unroll
                for (int m = 0; m < 4; ++m)
#pragma unroll
                    for (int n = 0; n < 2; ++n) acc[a][b][m][n] = (f32x4){0.f, 0.f, 0.f, 0.f};
        cur = nxt; cA = nA; cB = nB; ++ui;
        if constexpr (ALIGN_EPI) { if (wr == 1) PG8_BAR; }
    }
    PG8_WAIT_V(0);
    if constexpr (!ALIGN_EPI) { if (wr == 0) PG8_BAR; }
    PG8_BAR;
    if constexpr (Epi::AFTER_DRAIN) { E.fused(acc, cur, wr, wc, fr, fq, lds, wid, lane); S.done(cur); }
#undef PG8_SA
#undef PG8_SB
#undef PG8_STAGE
#undef PG8_LDA
#undef PG8_LDB
#undef PG8_MMA
#undef PG8_WAIT_V
#undef PG8_WAIT_L
#undef PG8_BAR
#undef PG8_SCHED
}
}
#define GAS __attribute__((address_space(1)))
#define LAS __attribute__((address_space(3)))
#define XB_TMO      128
#define XB_XCNT(j)  (256  + 64 * (j))
#define XB_XSUB(j)  (1280 + 64 * (j))
#define XB_XGEN(j)  (2304 + 64 * (j))
#define XB_TOP      3328
#define XB_TOPGEN   3392
#define XCD_BAR_WORDS 3456
#define XB_SPIN_CAP (1u << 18)

__device__ __forceinline__ unsigned xb_ld(unsigned* p)              { return __hip_atomic_load(p, __ATOMIC_RELAXED, __HIP_MEMORY_SCOPE_AGENT); }
__device__ __forceinline__ unsigned xb_add(unsigned* p, unsigned v) { return __hip_atomic_fetch_add(p, v, __ATOMIC_RELAXED, __HIP_MEMORY_SCOPE_AGENT); }
__device__ __forceinline__ unsigned xb_xcc_id() { return (unsigned)__builtin_amdgcn_s_getreg((3 << 11) | 20) & 0xFu; }
#define XB_SPIN(cond, bar) do { unsigned _sp = 0; while (cond) { __builtin_amdgcn_s_sleep(1); \
    if ((++_sp & 255u) == 0u) { if (xb_ld(&(bar)[XB_TMO])) break; if (_sp > XB_SPIN_CAP) { atomicAdd(&(bar)[XB_TMO], 1u); break; } } } } while (0)

struct XcdBarrier {
    unsigned* bar; unsigned x;
    volatile LAS unsigned* st;
};

__device__ __forceinline__ XcdBarrier xcd_barrier_post(unsigned* bar, volatile LAS unsigned* st) {
    XcdBarrier b; b.bar = bar; b.x = xb_xcc_id(); b.st = st;
    if (threadIdx.x == 0) (void)xb_add(&bar[XB_XCNT(b.x)], 1u);
    return b;
}
__device__ __forceinline__ void xcd_barrier_complete(unsigned* bar, unsigned x, unsigned& nloc, unsigned& nx) {
    const unsigned G = gridDim.x * gridDim.y * gridDim.z;
    unsigned sum, cnt, mine, sp = 0u;
    for (;;) {
        sum = 0u; cnt = 0u; mine = 0u;
#pragma unroll
        for (unsigned j = 0; j < 16; ++j) { const unsigned c = xb_ld(&bar[XB_XCNT(j)]); sum += c; cnt += (c > 0u) ? 1u : 0u; mine = (j == x) ? c : mine; }
        if (sum == G) break;
        __builtin_amdgcn_s_sleep(1);
        if ((++sp & 255u) == 0u) { if (xb_ld(&bar[XB_TMO])) break; if (sp > XB_SPIN_CAP) { atomicAdd(&bar[XB_TMO], 1u); break; } }
    }
    nloc = mine > 0u ? mine : 1u; nx = cnt > 0u ? cnt : 1u;
}

__device__ __forceinline__ void xcd_barrier(const XcdBarrier& b) {
    asm volatile("s_waitcnt vmcnt(0)" ::: "memory");
    __syncthreads();
    if (threadIdx.x == 0) {
        unsigned* bar = b.bar;
        __builtin_amdgcn_s_waitcnt(0);
        unsigned nloc = b.st[0], nx = b.st[1];
        if (nloc == 0u) { xcd_barrier_complete(bar, b.x, nloc, nx); b.st[0] = nloc; b.st[1] = nx; }
        const unsigned old = xb_add(&bar[XB_XSUB(b.x)], 1u);
        const unsigned gen = old / nloc;
        if (old + 1u == (gen + 1u) * nloc) {
            __builtin_amdgcn_fence(__ATOMIC_RELEASE, "agent");
            asm volatile("s_waitcnt vmcnt(0)" ::: "memory");
            const unsigned og = xb_add(&bar[XB_TOP], 1u);
            const unsigned tg = og / nx;
            if (og + 1u == (tg + 1u) * nx) xb_add(&bar[XB_TOPGEN], 1u);
            else XB_SPIN(xb_ld(&bar[XB_TOPGEN]) == tg, bar);
            __builtin_amdgcn_fence(__ATOMIC_ACQUIRE, "agent");
            xb_add(&bar[XB_XGEN(b.x)], 1u);
            asm volatile("s_waitcnt vmcnt(0)" ::: "memory");
        } else {
            XB_SPIN(xb_ld(&bar[XB_XGEN(b.x)]) == gen, bar);
            __builtin_amdgcn_fence(__ATOMIC_ACQUIRE, "agent");
            asm volatile("s_waitcnt vmcnt(0)" ::: "memory");
        }
    }
    __syncthreads();
}

#ifndef MK_N_LAUNCHES
#define MK_N_LAUNCHES 1
#endif
constexpr int NWAVES = 8;
constexpr int BATCH = 2, SEQ = 8192, D = 1024, M = BATCH * SEQ;
constexpr int NH = 8, HD = 64, AW = 512, PW = 512, INC = 4096;
constexpr int NE = 32, FF = 1024, PLE = 256, MOBA = 256, NBLK = SEQ / MOBA;
constexpr int QP = 2048;
constexpr int MAXROWS = M * 4 + NE * 256;
constexpr float RMS_EPS = 1e-6f;
constexpr float LOG2E = 1.4426950408889634f;
constexpr int NPH = 13;

constexpr size_t MiB = 1u << 20;
constexpr size_t WS_CTL = 0, CTL_ZERO_BYTES = 1 * MiB;
constexpr size_t WS_WIN = 2 * MiB, WS_WA = 10 * MiB, WS_WC = 11 * MiB, WS_WOUT = 12 * MiB, WS_WPG = 14 * MiB, WS_WPP = 16 * MiB;
constexpr size_t WS_RSTD0 = 17 * MiB, WS_KMEAN = WS_RSTD0 + 256 * 1024, WS_TOPI = WS_KMEAN + 256 * 1024, WS_TOPW = WS_TOPI + 256 * 1024;
constexpr size_t WS_INV = 18 * MiB, WS_ROWW = WS_INV + 256 * 1024;
constexpr size_t WS_WGU = 32 * MiB, WS_WD = 160 * MiB, WS_XB = 224 * MiB, WS_PB = 256 * MiB, WS_QKVU = 264 * MiB, WS_GATES = 328 * MiB;
constexpr size_t WS_PIN = 392 * MiB, WS_ATT = 408 * MiB, WS_TMP = 424 * MiB, WS_MERGED = 456 * MiB, WS_X1N = 488 * MiB;
constexpr size_t WS_XG = 520 * MiB, WS_H = 664 * MiB, WS_Y = 808 * MiB, WS_X2N = 952 * MiB, WS_PRJ = 984 * MiB, WS_END = 1016 * MiB;
static_assert(WS_ROWW + (size_t)MAXROWS * 4 <= 19 * MiB && WS_XG + (size_t)MAXROWS * 1024 * 2 <= WS_H && WS_Y + (size_t)MAXROWS * 1024 * 2 <= WS_X2N, "d_ws map");
constexpr int CW_TMO = 0, CW_CODE = 1, CW_BAR = 4096, CW_CNT = 16384, CW_TILES = 32768;
constexpr int LDS_BYTES = 147456, RING_BYTES = 131072, MISC_OFF = RING_BYTES + 320;

typedef unsigned short bf16;
typedef unsigned v4u __attribute__((ext_vector_type(4)));
typedef unsigned v2u __attribute__((ext_vector_type(2)));
typedef float f32x4 __attribute__((ext_vector_type(4)));
typedef GAS unsigned gu32;
#define RLX_AGENT __ATOMIC_RELAXED, __HIP_MEMORY_SCOPE_AGENT
#define LDS_WAIT() asm volatile("s_waitcnt lgkmcnt(0)" ::: "memory")
#define VM_WAIT() asm volatile("s_waitcnt vmcnt(0)" ::: "memory")
__device__ __forceinline__ unsigned f2bf(float f) { unsigned u = __builtin_bit_cast(unsigned, f); return (u + 0x7fffu + ((u >> 16) & 1u)) >> 16; }
__device__ __forceinline__ unsigned pk2(float lo, float hi) { return f2bf(lo) | (f2bf(hi) << 16); }
__device__ __forceinline__ float bflo(unsigned w) { return __uint_as_float(w << 16); }
__device__ __forceinline__ float bfhi(unsigned w) { return __uint_as_float(w & 0xffff0000u); }
__device__ __forceinline__ float bf2f(bf16 h) { return __uint_as_float((unsigned)h << 16); }
__device__ __forceinline__ float sigm(float x) { return __builtin_amdgcn_rcpf(1.0f + __builtin_amdgcn_exp2f(-LOG2E * x)); }
__device__ __forceinline__ float wave_sum(float v) {
#pragma unroll
    for (int o = 1; o < 64; o <<= 1) v += __shfl_xor(v, o);
    return v;
}
__device__ __forceinline__ float wave_max(float v) {
#pragma unroll
    for (int o = 1; o < 64; o <<= 1) v = fmaxf(v, __shfl_xor(v, o));
    return v;
}
__device__ __forceinline__ unsigned ld_ctl(const gu32* p) { return (unsigned)__builtin_amdgcn_readfirstlane((int)__hip_atomic_load(p, RLX_AGENT)); }

namespace mk {
using pg8::Unit; using pg8::BM; using pg8::HALF; using pg8::u32x4; using pg8::cvt_pk_bf16;
struct EpiInProj {
    static constexpr bool PERM = true, AFTER_DRAIN = false;
    bf16* qkvu; bf16* gates; const float* rstd;
    __device__ __forceinline__ void operator()(const f32x4 (&acc)[2][2][4][2], const Unit& u, int wr, int wc, int fr, int fq) const {
        const int row0 = u.pm * BM + wr * 64 + fr; const bool isg = u.pn >= 8;
        bf16* base = isg ? gates : qkvu; const int col0 = (u.pn & 7) * BM + wc * 32 + 8 * fq;
#pragma unroll
        for (int ai = 0; ai < 2; ++ai)
#pragma unroll
            for (int m = 0; m < 4; ++m) { const int row = row0 + ai * HALF + m * 16; const float rs = rstd[row]; bf16* rowp = base + (size_t)row * QP + col0;
#pragma unroll
                for (int bj = 0; bj < 2; ++bj) { f32x4 v0 = acc[ai][bj][m][0] * rs, v1 = acc[ai][bj][m][1] * rs;
                    if (isg) { v0 = (f32x4){sigm(v0[0]), sigm(v0[1]), sigm(v0[2]), sigm(v0[3])}; v1 = (f32x4){sigm(v1[0]), sigm(v1[1]), sigm(v1[2]), sigm(v1[3])}; }
                    u32x4 w; w.x = cvt_pk_bf16(v0[0], v0[1]); w.y = cvt_pk_bf16(v0[2], v0[3]); w.z = cvt_pk_bf16(v1[0], v1[1]); w.w = cvt_pk_bf16(v1[2], v1[3]);
                    *(u32x4*)(rowp + bj * HALF) = w; } }
    }
};
template <bool ADD> struct EpiGateMul {
    static constexpr bool PERM = true, AFTER_DRAIN = false;
    const bf16* gates; int goff; const bf16* add; bf16* out;
    __device__ __forceinline__ void operator()(const f32x4 (&acc)[2][2][4][2], const Unit& u, int wr, int wc, int fr, int fq) const {
        const int row0 = u.pm * BM + wr * 64 + fr; const int col0 = u.pn * BM + wc * 32 + 8 * fq;
#pragma unroll
        for (int ai = 0; ai < 2; ++ai)
#pragma unroll
            for (int m = 0; m < 4; ++m) { const int row = row0 + ai * HALF + m * 16;
#pragma unroll
                for (int bj = 0; bj < 2; ++bj) { const int c = col0 + bj * HALF;
                    const u32x4 g = *(const u32x4*)(gates + (size_t)row * QP + goff + c);
                    f32x4 v0 = acc[ai][bj][m][0] * (f32x4){bflo(g.x), bfhi(g.x), bflo(g.y), bfhi(g.y)}, v1 = acc[ai][bj][m][1] * (f32x4){bflo(g.z), bfhi(g.z), bflo(g.w), bfhi(g.w)};
                    if (ADD) { const u32x4 a = *(const u32x4*)(add + (size_t)row * D + c); v0 += (f32x4){bflo(a.x), bfhi(a.x), bflo(a.y), bfhi(a.y)}; v1 += (f32x4){bflo(a.z), bfhi(a.z), bflo(a.w), bfhi(a.w)}; }
                    u32x4 w; w.x = cvt_pk_bf16(v0[0], v0[1]); w.y = cvt_pk_bf16(v0[2], v0[3]); w.z = cvt_pk_bf16(v1[0], v1[1]); w.w = cvt_pk_bf16(v1[2], v1[3]);
                    *(u32x4*)(out + (size_t)row * D + c) = w; } }
    }
};
struct EpiResF32 {
    static constexpr bool PERM = false, AFTER_DRAIN = false;
    const float* base; float* out;
    __device__ __forceinline__ void operator()(const f32x4 (&acc)[2][2][4][2], const Unit& u, int wr, int wc, int fr, int fq) const {
        const int row0 = u.pm * BM + wr * 64 + fr; const int col0 = u.pn * BM + wc * 32 + 4 * fq;
#pragma unroll
        for (int ai = 0; ai < 2; ++ai)
#pragma unroll
            for (int m = 0; m < 4; ++m) { const size_t off = (size_t)(row0 + ai * HALF + m * 16) * D + col0;
#pragma unroll
                for (int bj = 0; bj < 2; ++bj)
#pragma unroll
                    for (int n = 0; n < 2; ++n) { const f32x4 b = *(const f32x4*)(base + off + bj * HALF + n * 16); *(f32x4*)(out + off + bj * HALF + n * 16) = b + acc[ai][bj][m][n]; } }
    }
};
__device__ __forceinline__ float glu1(float g, float l) { g = fminf(g, 7.0f); l = fminf(fmaxf(l, -7.0f), 7.0f); return (l + 1.0f) * g * __builtin_amdgcn_rcpf(1.0f + __builtin_amdgcn_exp2f(-1.702f * LOG2E * g)); }
struct EpiGlu {
    static constexpr bool PERM = true, AFTER_DRAIN = false;
    const float* bgu; bf16* H;
    __device__ __forceinline__ void operator()(const f32x4 (&acc)[2][2][4][2], const Unit& u, int wr, int wc, int fr, int fq) const {
        const int e = u.pn >> 3, pnl = u.pn & 7; const int row0 = u.pm * BM + wr * 64 + fr; const int col0 = pnl * BM + wc * 32 + 8 * fq;
        f32x4 bv[2][2];
#pragma unroll
        for (int bj = 0; bj < 2; ++bj)
#pragma unroll
            for (int n = 0; n < 2; ++n) bv[bj][n] = *(const f32x4*)(bgu + (size_t)e * 2048 + col0 + bj * HALF + 4 * n);
#pragma unroll
        for (int ai = 0; ai < 2; ++ai)
#pragma unroll
            for (int m = 0; m < 4; ++m) { const int row = row0 + ai * HALF + m * 16;
#pragma unroll
                for (int bj = 0; bj < 2; ++bj) { const f32x4 v0 = acc[ai][bj][m][0] + bv[bj][0], v1 = acc[ai][bj][m][1] + bv[bj][1];
                    v2u w; w.x = cvt_pk_bf16(glu1(v0[0], v0[1]), glu1(v0[2], v0[3])); w.y = cvt_pk_bf16(glu1(v1[0], v1[1]), glu1(v1[2], v1[3]));
                    *(v2u*)(H + (size_t)row * FF + ((col0 + bj * HALF) >> 1)) = w; } }
    }
};
struct EpiDown {
    static constexpr bool PERM = true, AFTER_DRAIN = false;
    const float* bd; const float* roww; bf16* Y;
    __device__ __forceinline__ void operator()(const f32x4 (&acc)[2][2][4][2], const Unit& u, int wr, int wc, int fr, int fq) const {
        const int e = u.pn >> 2, pnl = u.pn & 3; const int row0 = u.pm * BM + wr * 64 + fr; const int col0 = pnl * BM + wc * 32 + 8 * fq;
        f32x4 bv[2][2];
#pragma unroll
        for (int bj = 0; bj < 2; ++bj)
#pragma unroll
            for (int n = 0; n < 2; ++n) bv[bj][n] = *(const f32x4*)(bd + (size_t)e * D + col0 + bj * HALF + 4 * n);
#pragma unroll
        for (int ai = 0; ai < 2; ++ai)
#pragma unroll
            for (int m = 0; m < 4; ++m) { const int row = row0 + ai * HALF + m * 16; const float rw = roww[row];
#pragma unroll
                for (int bj = 0; bj < 2; ++bj) { const f32x4 v0 = (acc[ai][bj][m][0] + bv[bj][0]) * rw, v1 = (acc[ai][bj][m][1] + bv[bj][1]) * rw;
                    u32x4 w; w.x = cvt_pk_bf16(v0[0], v0[1]); w.y = cvt_pk_bf16(v0[2], v0[3]); w.z = cvt_pk_bf16(v1[0], v1[1]); w.w = cvt_pk_bf16(v1[2], v1[3]);
                    *(u32x4*)(Y + (size_t)row * D + col0 + bj * HALF) = w; } }
    }
};
struct EpiBf {
    static constexpr bool PERM = true, AFTER_DRAIN = false;
    bf16* out;
    __device__ __forceinline__ void operator()(const f32x4 (&acc)[2][2][4][2], const Unit& u, int wr, int wc, int fr, int fq) const {
        const int row0 = u.pm * BM + wr * 64 + fr; const int col0 = u.pn * BM + wc * 32 + 8 * fq;
#pragma unroll
        for (int ai = 0; ai < 2; ++ai)
#pragma unroll
            for (int m = 0; m < 4; ++m) { bf16* rowp = out + (size_t)(row0 + ai * HALF + m * 16) * D + col0;
#pragma unroll
                for (int bj = 0; bj < 2; ++bj) { const f32x4 v0 = acc[ai][bj][m][0], v1 = acc[ai][bj][m][1];
                    u32x4 w; w.x = cvt_pk_bf16(v0[0], v0[1]); w.y = cvt_pk_bf16(v0[2], v0[3]); w.z = cvt_pk_bf16(v1[0], v1[1]); w.w = cvt_pk_bf16(v1[2], v1[3]);
                    *(u32x4*)(rowp + bj * HALF) = w; } }
    }
};
struct EpiPle {
    static constexpr bool PERM = false, AFTER_DRAIN = false;
    float* xio; const bf16* prj;
    __device__ __forceinline__ void operator()(const f32x4 (&acc)[2][2][4][2], const Unit& u, int wr, int wc, int fr, int fq) const {
        const int row0 = u.pm * BM + wr * 64 + fr; const int col0 = u.pn * BM + wc * 32 + 4 * fq;
#pragma unroll
        for (int ai = 0; ai < 2; ++ai)
#pragma unroll
            for (int m = 0; m < 4; ++m) { const size_t off = (size_t)(row0 + ai * HALF + m * 16) * D + col0;
#pragma unroll
                for (int bj = 0; bj < 2; ++bj)
#pragma unroll
                    for (int n = 0; n < 2; ++n) { const size_t c = off + bj * HALF + n * 16; const f32x4 xv = *(const f32x4*)(xio + c); const v2u p = *(const v2u*)(prj + c); const f32x4 a = acc[ai][bj][m][n];
                        *(f32x4*)(xio + c) = xv + (f32x4){sigm(a[0]) * bflo(p.x), sigm(a[1]) * bfhi(p.x), sigm(a[2]) * bflo(p.y), sigm(a[3]) * bfhi(p.y)}; } }
    }
};
struct MoeOrder {
    const gu32* tiles; int TM, NT, G, c;
    __device__ __forceinline__ void init(const gu32* t, int nt, int G_, int c_) { tiles = t; NT = nt; G = G_; c = c_; TM = (int)ld_ctl(t); }
    __device__ __forceinline__ bool next(int i, Unit& u) const {
        const long L = (long)i * G + c; if (L >= (long)TM * NT) return false;
        const int mt = (int)(L / NT), pn = (int)(L % NT);
        u.pm = (int)ld_ctl(tiles + 64 + 2 * mt); u.pn = (int)ld_ctl(tiles + 64 + 2 * mt + 1) * NT + pn; return true;
    }
    __device__ __forceinline__ void a_ready(const Unit&) const {}
    __device__ __forceinline__ void done(const Unit&) const {}
};
}

__device__ __forceinline__ void tr_item(const float* W, int K, int N, const float* ks, bf16* WT, LAS float* scr, int item, int lane) {
    const int nblk = N / 32, kb = item / nblk, nb = item % nblk, k0 = 64 * kb, n0 = 32 * nb;
#pragma unroll 8
    for (int i = 0; i < 32; ++i) { const int kk = 2 * i + (lane >> 5); float v = W[(size_t)(k0 + kk) * N + n0 + (lane & 31)]; if (ks) v *= ks[k0 + kk]; scr[kk * 33 + (lane & 31)] = v; }
    LDS_WAIT(); asm volatile("" ::: "memory");
    const int c = lane & 7;
#pragma unroll
    for (int j = 0; j < 4; ++j) { const int n = (lane >> 3) + 8 * j; const LAS float* s = scr + (8 * c) * 33 + n;
        v4u o; o.x = pk2(s[0 * 33], s[1 * 33]); o.y = pk2(s[2 * 33], s[3 * 33]); o.z = pk2(s[4 * 33], s[5 * 33]); o.w = pk2(s[6 * 33], s[7 * 33]);
        *(GAS v4u*)(WT + (size_t)(n0 + n) * K + k0 + 8 * c) = o; }
    LDS_WAIT(); asm volatile("" ::: "memory");
}

struct Ptrs {
    const float *x, *p, *relb, *g_mix, *w_in, *pool_w, *pool_scale, *w_oa, *w_op, *w_out, *g_ffn, *rw, *rb, *w_gu, *b_gu, *w_d, *b_d, *g_ple, *w_pg, *w_pp, *g_fin;
    float* out; unsigned char* ws; gu32* ctl;
    bf16 *WinT, *WaT, *WcT, *WoutT, *WpgT, *WppT, *WguT, *WdT, *XB, *PB, *QKVU, *GATES, *PIN, *ATT, *TMP, *MERGED, *X1N, *XG, *H, *Y, *X2N, *PRJ;
    float *RSTD0, *KMEAN, *TOPW, *ROWW; int *TOPI, *INV;
};

__device__ __forceinline__ void p0_prologue(const Ptrs& P, LAS unsigned char* lds, int gw, int NGW, int wave, int lane) {
    LAS float* scr = (LAS float*)(lds + wave * 16384);
    constexpr int I_IN = 16 * 128, I_OA = 8 * 32, I_OUT = 16 * 32, I_PG = 16 * 32, I_PP = 4 * 32, I_GU1 = 16 * 64, I_D1 = 16 * 32;
    constexpr int I_GU = NE * I_GU1, I_D = NE * I_D1, NITEMS = I_IN + I_OA + I_OUT + I_PG + I_PP + I_GU + I_D;
    for (int it = gw; it < NITEMS; it += NGW) {
        int r = it;
        if (r < I_GU) { const int e = r / I_GU1; tr_item(P.w_gu + (size_t)e * D * 2048, D, 2048, P.g_ffn, P.WguT + (size_t)e * 2048 * D, scr, r % I_GU1, lane); continue; } r -= I_GU;
        if (r < I_D) { const int e = r / I_D1; tr_item(P.w_d + (size_t)e * FF * D, FF, D, nullptr, P.WdT + (size_t)e * D * FF, scr, r % I_D1, lane); continue; } r -= I_D;
        if (r < I_IN) { tr_item(P.w_in, D, INC, P.g_mix, P.WinT, scr, r, lane); continue; } r -= I_IN;
        if (r < I_OA) { tr_item(P.w_oa, AW, D, nullptr, P.WaT, scr, r, lane); continue; } r -= I_OA;
        if (r < I_OUT) { tr_item(P.w_out, D, D, nullptr, P.WoutT, scr, r, lane); continue; } r -= I_OUT;
        if (r < I_PG) { tr_item(P.w_pg, D, D, P.g_ple, P.WpgT, scr, r, lane); continue; } r -= I_PG;
        tr_item(P.w_pp, PLE, D, nullptr, P.WppT, scr, r, lane);
    }
    for (int it = gw; it < 512 * 4; it += NGW) {
        const int k = it >> 2, n0 = (it & 3) * 256 + lane * 4, g = k >> 7;
        f32x4 a = {0.f, 0.f, 0.f, 0.f};
        for (int j = 0; j < 128; ++j) { const float s = P.pool_w[(size_t)k * 128 + j] * P.pool_scale[g * 128 + j]; const f32x4 w = *(const f32x4*)(P.w_op + (size_t)(g * 128 + j) * D + n0); a += w * s; }
#pragma unroll
        for (int i = 0; i < 4; ++i) P.WcT[(size_t)(n0 + i) * PW + k] = (bf16)f2bf(a[i]);
    }
    for (int m = gw; m < M; m += NGW) {
        const GAS f32x4* xr = (const GAS f32x4*)(P.x + (size_t)m * D) + lane; f32x4 v[4]; float s = 0.f;
#pragma unroll
        for (int j = 0; j < 4; ++j) { v[j] = xr[64 * j]; s += (v[j].x * v[j].x + v[j].y * v[j].y) + (v[j].z * v[j].z + v[j].w * v[j].w); }
        s = wave_sum(s); if (lane == 0) P.RSTD0[m] = 1.0f / sqrtf(s * (1.0f / D) + RMS_EPS);
        GAS unsigned long long* o8 = (GAS unsigned long long*)(P.XB + (size_t)m * D) + lane;
#pragma unroll
        for (int j = 0; j < 4; ++j) o8[64 * j] = (unsigned long long)pk2(v[j].x, v[j].y) | ((unsigned long long)pk2(v[j].z, v[j].w) << 32);
    }
    for (int i = gw * 64 + lane; i < M * PLE / 8; i += NGW * 64) { const f32x4 a = ((const f32x4*)P.p)[2 * i], b = ((const f32x4*)P.p)[2 * i + 1];
        v4u o; o.x = pk2(a.x, a.y); o.y = pk2(a.z, a.w); o.z = pk2(b.x, b.y); o.w = pk2(b.z, b.w); ((v4u*)P.PB)[i] = o; }
}

__device__ __forceinline__ void p2_kmean_pin(const Ptrs& P, int gw, int NGW, int lane) {
    for (int it = gw; it < BATCH * NBLK * NH; it += NGW) {
        const int h = it & 7, n = (it >> 3) & 31, b = it >> 8;
        const bf16* kp = P.QKVU + (size_t)(b * SEQ + n * MOBA) * QP + AW + h * HD + lane; float s = 0.f;
#pragma unroll 8
        for (int i = 0; i < MOBA; ++i) s += bf2f(kp[(size_t)i * QP]);
        P.KMEAN[((size_t)(b * NH + h) * NBLK + n) * HD + lane] = s * (1.0f / MOBA);
    }
    for (int r = gw; r < M; r += NGW) {
        const int s = r & (SEQ - 1), g = lane >> 4, w = 2 << g; const int cnt = (s + 1 < w) ? s + 1 : w;
        const bf16* up = P.QKVU + (size_t)r * QP + 3 * AW + lane * 8; float a[8];
#pragma unroll
        for (int i = 0; i < 8; ++i) a[i] = 0.f;
        for (int i = 0; i < 16; ++i) if (i < cnt) { const v4u q = *(const v4u*)(up - (size_t)i * QP);
            a[0] += bflo(q.x); a[1] += bfhi(q.x); a[2] += bflo(q.y); a[3] += bfhi(q.y); a[4] += bflo(q.z); a[5] += bfhi(q.z); a[6] += bflo(q.w); a[7] += bfhi(q.w); }
        const v4u q = *(const v4u*)up; const float ic = 1.0f / (float)cnt;
        v4u o; o.x = pk2(a[0] * ic - bflo(q.x), a[1] * ic - bfhi(q.x)); o.y = pk2(a[2] * ic - bflo(q.y), a[3] * ic - bfhi(q.y));
        o.z = pk2(a[4] * ic - bflo(q.z), a[5] * ic - bfhi(q.z)); o.w = pk2(a[6] * ic - bflo(q.w), a[7] * ic - bfhi(q.w));
        *(v4u*)(P.PIN + (size_t)r * PW + lane * 8) = o;
    }
}

__device__ __forceinline__ int t5_bucket(int rel) {
    const int n = rel < 0 ? 0 : rel; if (n < 16) return n;
    int b = 16; b += (n >= 19); b += (n >= 21); b += (n >= 24); b += (n >= 27); b += (n >= 31); b += (n >= 35); b += (n >= 40); b += (n >= 46);
    b += (n >= 52); b += (n >= 59); b += (n >= 67); b += (n >= 77); b += (n >= 87); b += (n >= 99); b += (n >= 113); return b;
}

__device__ __forceinline__ void p3_attn_simple(const Ptrs& P, int gw, int NGW, int lane) {
    const float NEG = -INFINITY;
    for (int idx = gw; idx < M * NH; idx += NGW) {
        const int t = idx >> 3, h = idx & 7, b = t >> 13, s = t & (SEQ - 1), j = s >> 8;
        const float qv = bf2f(P.QKVU[(size_t)t * QP + h * HD + lane]) * 0.125f;
        float qs[64];
#pragma unroll
        for (int d = 0; d < 64; ++d) qs[d] = __builtin_bit_cast(float, __builtin_amdgcn_readlane(__builtin_bit_cast(int, qv), d));
        float g = NEG;
        if (lane < j) { const float* km = P.KMEAN + ((size_t)(b * NH + h) * NBLK + lane) * HD; float a = 0.f;
#pragma unroll
            for (int d = 0; d < 64; ++d) a += qs[d] * km[d];
            g = a; }
        int sel[3];
#pragma unroll
        for (int r = 0; r < 3; ++r) { const float mx = wave_max(g); const unsigned long long bal = __ballot(g == mx); const int ix = __ffsll((long long)bal) - 1; sel[r] = ix; if (lane == ix) g = NEG; }
        const int nvalid = j < 3 ? j : 3;
        float m = NEG, l = 0.f, o = 0.f;
        for (int pc = 0; pc <= nvalid; ++pc) {
            const int n = (pc == 0) ? j : (pc == 1 ? sel[0] : (pc == 2 ? sel[1] : sel[2]));
            const int nch = (pc == 0) ? (((s & 255) >> 6) + 1) : 4;
            for (int c = 0; c < nch; ++c) {
                const int key = n * MOBA + c * 64 + lane, rel = s - key;
                const v4u* kr = (const v4u*)(P.QKVU + (size_t)(b * SEQ + key) * QP + AW + h * HD);
                float sc = 0.f;
#pragma unroll
                for (int i = 0; i < 8; ++i) { const v4u w = kr[i];
                    sc += qs[8 * i] * bflo(w.x) + qs[8 * i + 1] * bfhi(w.x) + qs[8 * i + 2] * bflo(w.y) + qs[8 * i + 3] * bfhi(w.y) + qs[8 * i + 4] * bflo(w.z) + qs[8 * i + 5] * bfhi(w.z) + qs[8 * i + 6] * bflo(w.w) + qs[8 * i + 7] * bfhi(w.w); }
                sc += P.relb[t5_bucket(rel) * NH + h]; if (rel < 0) sc = NEG;
                const float cm = wave_max(sc), mn = fmaxf(m, cm);
                const float pr = __builtin_amdgcn_exp2f((sc - mn) * LOG2E), al = __builtin_amdgcn_exp2f((m - mn) * LOG2E);
                l = l * al + wave_sum(pr); o *= al; m = mn;
                const bf16* vb = P.QKVU + (size_t)(b * SEQ + n * MOBA + c * 64) * QP + 2 * AW + h * HD + lane;
#pragma unroll 16
                for (int kk = 0; kk < 64; ++kk) o += __builtin_bit_cast(float, __builtin_amdgcn_readlane(__builtin_bit_cast(int, pr), kk)) * bf2f(vb[(size_t)kk * QP]);
            }
        }
        P.ATT[(size_t)t * AW + h * HD + lane] = (bf16)f2bf(o / l);
    }
}

__device__ __forceinline__ void p6_router(const Ptrs& P, LAS unsigned char* lds, int G, int tid, int wave, int lane) {
    LAS float* XS = (LAS float*)lds;
    LAS float* PART = (LAS float*)(lds + 65536);
    LAS float* LG = (LAS float*)(lds + 98304);
    LAS float* RS = (LAS float*)(lds + 100352);
    LAS unsigned* HIST = (LAS unsigned*)(lds + 100480);
    const int e = lane & 31, kq = lane >> 5, kbase = 128 * wave + 64 * kq;
    float wreg[64];
#pragma unroll
    for (int i = 0; i < 64; ++i) wreg[i] = P.rw[(size_t)(kbase + i) * NE + e] * P.g_ffn[kbase + i];
    for (int chunk = blockIdx.x; chunk < M / 64; chunk += G) {
        if (tid < 32) HIST[tid] = 0u;
        for (int bt = 0; bt < 4; ++bt) {
            __syncthreads();
#pragma unroll
            for (int tt = 0; tt < 2; ++tt) { const int tl = wave * 2 + tt, row = chunk * 64 + bt * 16 + tl;
                const GAS f32x4* xr = (const GAS f32x4*)(P.out + (size_t)row * D) + lane; f32x4 v[4]; float s = 0.f;
#pragma unroll
                for (int j = 0; j < 4; ++j) { v[j] = xr[64 * j]; s += (v[j].x * v[j].x + v[j].y * v[j].y) + (v[j].z * v[j].z + v[j].w * v[j].w); }
                s = wave_sum(s); const float rs = 1.0f / sqrtf(s * (1.0f / D) + RMS_EPS);
                GAS unsigned long long* o8 = (GAS unsigned long long*)(P.X1N + (size_t)row * D) + lane;
#pragma unroll
                for (int j = 0; j < 4; ++j) { *(LAS f32x4*)(XS + tl * 1024 + 4 * lane + 256 * j) = v[j];
                    o8[64 * j] = (unsigned long long)pk2(v[j].x * rs, v[j].y * rs) | ((unsigned long long)pk2(v[j].z * rs, v[j].w * rs) << 32); }
                if (lane == 0) RS[tl] = rs; }
            __syncthreads();
            for (int tl = 0; tl < 16; ++tl) { float a = 0.f;
#pragma unroll
                for (int i4 = 0; i4 < 16; ++i4) { const f32x4 xv = *(const LAS f32x4*)(XS + tl * 1024 + kbase + 4 * i4);
                    a += xv.x * wreg[4 * i4] + xv.y * wreg[4 * i4 + 1] + xv.z * wreg[4 * i4 + 2] + xv.w * wreg[4 * i4 + 3]; }
                PART[(tl * 16 + wave * 2 + kq) * 32 + e] = a; }
            __syncthreads();
            { const int tl = tid >> 5, ee = tid & 31; float a = 0.f;
#pragma unroll
                for (int q = 0; q < 16; ++q) a += PART[(tl * 16 + q) * 32 + ee];
                LG[tl * 32 + ee] = a * RS[tl] + P.rb[ee]; }
            __syncthreads();
            { const int tl = wave * 2 + kq, row = chunk * 64 + bt * 16 + tl; float v = LG[tl * 32 + e]; float tv[4]; int ti[4];
#pragma unroll
                for (int r = 0; r < 4; ++r) { float mx = v;
#pragma unroll
                    for (int o = 1; o < 32; o <<= 1) mx = fmaxf(mx, __shfl_xor(mx, o));
                    const unsigned long long bal = __ballot(v == mx); const unsigned hm = kq ? (unsigned)(bal >> 32) : (unsigned)bal; const int ix = __ffs((int)hm) - 1;
                    tv[r] = mx; ti[r] = ix; if (e == ix) v = -INFINITY; }
                const float e1 = __builtin_amdgcn_exp2f((tv[1] - tv[0]) * LOG2E), e2 = __builtin_amdgcn_exp2f((tv[2] - tv[0]) * LOG2E), e3 = __builtin_amdgcn_exp2f((tv[3] - tv[0]) * LOG2E);
                const float inv = 1.0f / (1.0f + e1 + e2 + e3);
                if (e == 0) { P.TOPI[row * 4 + 0] = ti[0]; P.TOPI[row * 4 + 1] = ti[1]; P.TOPI[row * 4 + 2] = ti[2]; P.TOPI[row * 4 + 3] = ti[3];
                    P.TOPW[row * 4 + 0] = inv; P.TOPW[row * 4 + 1] = e1 * inv; P.TOPW[row * 4 + 2] = e2 * inv; P.TOPW[row * 4 + 3] = e3 * inv;
                    __hip_atomic_fetch_add(HIST + ti[0], 1u, __ATOMIC_RELAXED, __HIP_MEMORY_SCOPE_WORKGROUP); __hip_atomic_fetch_add(HIST + ti[1], 1u, __ATOMIC_RELAXED, __HIP_MEMORY_SCOPE_WORKGROUP); __hip_atomic_fetch_add(HIST + ti[2], 1u, __ATOMIC_RELAXED, __HIP_MEMORY_SCOPE_WORKGROUP); __hip_atomic_fetch_add(HIST + ti[3], 1u, __ATOMIC_RELAXED, __HIP_MEMORY_SCOPE_WORKGROUP); } }
        }
        __syncthreads();
        if (tid < 32) P.ctl[CW_CNT + chunk * 32 + tid] = HIST[tid];
        __syncthreads();
    }
}

__device__ __forceinline__ void p7_permute(const Ptrs& P, LAS unsigned char* lds, int G, int tid, int wave, int lane) {
    LAS unsigned* SUMT = (LAS unsigned*)lds;
    LAS unsigned* SUMB = SUMT + 512;
    LAS unsigned* TOT = SUMB + 512;
    LAS unsigned* BASEP = TOT + 32; LAS unsigned* NTM = BASEP + 32; LAS unsigned* PST = NTM + 32;
    LAS unsigned* ES = PST + 32;
    LAS unsigned* POS = ES + 256;
    for (int chunk = blockIdx.x; chunk < M / 64; chunk += G) {
        { const int e = tid & 31, part = tid >> 5; unsigned st = 0u, sb = 0u;
            for (int c = 16 * part; c < 16 * part + 16; ++c) { const unsigned v = __hip_atomic_load(P.ctl + CW_CNT + c * 32 + e, RLX_AGENT); st += v; if (c < chunk) sb += v; }
            SUMT[part * 32 + e] = st; SUMB[part * 32 + e] = sb; }
        __syncthreads();
        if (tid < 32) { unsigned st = 0u, sb = 0u;
            for (int q = 0; q < 16; ++q) { st += SUMT[q * 32 + tid]; sb += SUMB[q * 32 + tid]; }
            TOT[tid] = st; BASEP[tid] = sb; NTM[tid] = (st + 255u) >> 8; }
        __syncthreads();
        if (tid < 32) { unsigned ps = 0u; for (int q = 0; q < tid; ++q) ps += NTM[q]; PST[tid] = ps * 256u; }
        if (tid < 256) ES[tid] = (unsigned)P.TOPI[(chunk * 64 + (tid >> 2)) * 4 + (tid & 3)];
        __syncthreads();
        if (tid < 256) { const unsigned e = ES[tid]; unsigned rank = 0u;
            for (int a = 0; a < tid; ++a) rank += (ES[a] == e) ? 1u : 0u;
            const unsigned pos = PST[e] + BASEP[e] + rank; const int ta = (chunk * 64 + (tid >> 2)) * 4 + (tid & 3);
            P.INV[ta] = (int)pos; P.ROWW[pos] = P.TOPW[ta]; POS[tid] = pos; }
        __syncthreads();
        for (int a = wave * 32; a < wave * 32 + 32; ++a) { const int tok = chunk * 64 + (a >> 2); const unsigned pos = POS[a];
            const v4u* src = (const v4u*)(P.X1N + (size_t)tok * D); v4u* dst = (v4u*)(P.XG + (size_t)pos * D);
            const v4u a0 = src[lane], a1 = src[lane + 64]; dst[lane] = a0; dst[lane + 64] = a1; }
        if (chunk < NE) { const unsigned r0 = PST[chunk] + TOT[chunk], r1 = PST[chunk] + NTM[chunk] * 256u;
            for (unsigned r = r0 + wave; r < r1; r += NWAVES) { v4u* dst = (v4u*)(P.XG + (size_t)r * D); const v4u z = {0u, 0u, 0u, 0u}; dst[lane] = z; dst[lane + 64] = z; if (lane == 0) P.ROWW[r] = 0.f; } }
        if (chunk == 0) { if (tid < 32) { const unsigned pm0 = PST[tid] >> 8; for (unsigned k = 0; k < NTM[tid]; ++k) { P.ctl[CW_TILES + 64 + 2 * (pm0 + k)] = pm0 + k; P.ctl[CW_TILES + 64 + 2 * (pm0 + k) + 1] = (unsigned)tid; } }
            if (tid == 0) P.ctl[CW_TILES] = (PST[31] >> 8) + NTM[31]; }
        __syncthreads();
    }
}

__device__ __forceinline__ void p10_combine(const Ptrs& P, int gw, int NGW, int lane) {
    for (int m = gw; m < M; m += NGW) {
        GAS f32x4* xr = (GAS f32x4*)(P.out + (size_t)m * D) + lane; f32x4 v[4];
#pragma unroll
        for (int j = 0; j < 4; ++j) v[j] = xr[64 * j];
#pragma unroll
        for (int k = 0; k < 4; ++k) { const int pos = P.INV[m * 4 + k]; const v2u* yr = (const v2u*)(P.Y + (size_t)pos * D) + lane;
#pragma unroll
            for (int j = 0; j < 4; ++j) { const v2u y = yr[64 * j]; v[j] += (f32x4){bflo(y.x), bfhi(y.x), bflo(y.y), bfhi(y.y)}; } }
        float s = 0.f;
#pragma unroll
        for (int j = 0; j < 4; ++j) s += (v[j].x * v[j].x + v[j].y * v[j].y) + (v[j].z * v[j].z + v[j].w * v[j].w);
        s = wave_sum(s); const float rs = 1.0f / sqrtf(s * (1.0f / D) + RMS_EPS);
        GAS unsigned long long* o8 = (GAS unsigned long long*)(P.X2N + (size_t)m * D) + lane;
#pragma unroll
        for (int j = 0; j < 4; ++j) { xr[64 * j] = v[j]; o8[64 * j] = (unsigned long long)pk2(v[j].x * rs, v[j].y * rs) | ((unsigned long long)pk2(v[j].z * rs, v[j].w * rs) << 32); }
    }
}

__device__ __forceinline__ void p12_final(const Ptrs& P, int gw, int NGW, int lane) {
    const GAS f32x4* gr = (const GAS f32x4*)P.g_fin + lane; f32x4 gv[4];
#pragma unroll
    for (int j = 0; j < 4; ++j) gv[j] = gr[64 * j];
    for (int m = gw; m < M; m += NGW) {
        GAS f32x4* xr = (GAS f32x4*)(P.out + (size_t)m * D) + lane; f32x4 v[4]; float s = 0.f;
#pragma unroll
        for (int j = 0; j < 4; ++j) { v[j] = xr[64 * j]; s += (v[j].x * v[j].x + v[j].y * v[j].y) + (v[j].z * v[j].z + v[j].w * v[j].w); }
        s = wave_sum(s); const float rs = 1.0f / sqrtf(s * (1.0f / D) + RMS_EPS);
#pragma unroll
        for (int j = 0; j < 4; ++j) xr[64 * j] = v[j] * rs * gv[j];
    }
}

struct Args { const float* in[21]; float* out; unsigned char* ws; int ph_lo, ph_hi; };
__global__ void __launch_bounds__(NWAVES * 64, 2) mk_fwd(Args args) {
    __shared__ __attribute__((aligned(16))) unsigned char lds_raw[LDS_BYTES];
    LAS unsigned char* lds = (LAS unsigned char*)lds_raw;
    volatile LAS unsigned* MISC = (volatile LAS unsigned*)(lds + MISC_OFF);
    const int tid = threadIdx.x, lane = tid & 63, wave = __builtin_amdgcn_readfirstlane(tid >> 6);
    const int G = gridDim.x; const int bx = blockIdx.x; const int vcu = (G % 8 == 0) ? (bx % 8) * (G / 8) + bx / 8 : bx;
    const int gw = vcu * NWAVES + wave, NGW = G * NWAVES;
    Ptrs P; unsigned char* ws = args.ws;
    P.x = args.in[0]; P.p = args.in[1]; P.relb = args.in[2]; P.g_mix = args.in[3]; P.w_in = args.in[4]; P.pool_w = args.in[5]; P.pool_scale = args.in[6]; P.w_oa = args.in[7];
    P.w_op = args.in[8]; P.w_out = args.in[9]; P.g_ffn = args.in[10]; P.rw = args.in[11]; P.rb = args.in[12]; P.w_gu = args.in[13]; P.b_gu = args.in[14]; P.w_d = args.in[15];
    P.b_d = args.in[16]; P.g_ple = args.in[17]; P.w_pg = args.in[18]; P.w_pp = args.in[19]; P.g_fin = args.in[20];
    P.out = args.out; P.ws = ws; P.ctl = (gu32*)(ws + WS_CTL);
    P.WinT = (bf16*)(ws + WS_WIN); P.WaT = (bf16*)(ws + WS_WA); P.WcT = (bf16*)(ws + WS_WC); P.WoutT = (bf16*)(ws + WS_WOUT); P.WpgT = (bf16*)(ws + WS_WPG); P.WppT = (bf16*)(ws + WS_WPP);
    P.WguT = (bf16*)(ws + WS_WGU); P.WdT = (bf16*)(ws + WS_WD); P.XB = (bf16*)(ws + WS_XB); P.PB = (bf16*)(ws + WS_PB); P.QKVU = (bf16*)(ws + WS_QKVU); P.GATES = (bf16*)(ws + WS_GATES);
    P.PIN = (bf16*)(ws + WS_PIN); P.ATT = (bf16*)(ws + WS_ATT); P.TMP = (bf16*)(ws + WS_TMP); P.MERGED = (bf16*)(ws + WS_MERGED); P.X1N = (bf16*)(ws + WS_X1N); P.XG = (bf16*)(ws + WS_XG);
    P.H = (bf16*)(ws + WS_H); P.Y = (bf16*)(ws + WS_Y); P.X2N = (bf16*)(ws + WS_X2N); P.PRJ = (bf16*)(ws + WS_PRJ);
    P.RSTD0 = (float*)(ws + WS_RSTD0); P.KMEAN = (float*)(ws + WS_KMEAN); P.TOPW = (float*)(ws + WS_TOPW); P.ROWW = (float*)(ws + WS_ROWW); P.TOPI = (int*)(ws + WS_TOPI); P.INV = (int*)(ws + WS_INV);

    for (int u = tid; u < (LDS_BYTES - RING_BYTES) / 4; u += NWAVES * 64) ((LAS unsigned*)(lds + RING_BYTES))[u] = 0u;
    __syncthreads();
    XcdBarrier bar; bar.bar = (unsigned*)(P.ctl + CW_BAR); bar.x = 0; bar.st = nullptr;
    if (MK_N_LAUNCHES == 1) bar = xcd_barrier_post((unsigned*)(P.ctl + CW_BAR), MISC + 8);
    const int lo = args.ph_lo, hi = args.ph_hi;
#define IN(k) (lo <= (k) && (k) < hi)
#define SEAM(k) do { if (IN(k) && IN((k) + 1)) xcd_barrier(bar); } while (0)

    if (IN(0)) { p0_prologue(P, lds, gw, NGW, wave, lane); } SEAM(0);
    if (IN(1)) { pg8::Gemm g{P.XB, P.WinT, M, INC, D}; pg8::StaticOrder S; S.init(M, INC, G, bx);
        mk::EpiInProj E{P.QKVU, P.GATES, P.RSTD0}; pg8::gemm_phase<mk::EpiInProj, pg8::StaticOrder, true, true>(lds, g, S, E); } SEAM(1);
    if (IN(2)) { p2_kmean_pin(P, gw, NGW, lane); } SEAM(2);
    if (IN(3)) { p3_attn_simple(P, gw, NGW, lane); } SEAM(3);
    if (IN(4)) {
        { pg8::Gemm g{P.ATT, P.WaT, M, D, AW}; pg8::StaticOrder S; S.init(M, D, G, bx);
          mk::EpiGateMul<false> E{P.GATES, 0, nullptr, P.TMP}; pg8::gemm_phase<mk::EpiGateMul<false>, pg8::StaticOrder, true, true>(lds, g, S, E); }
        VM_WAIT(); __syncthreads();
        { pg8::Gemm g{P.PIN, P.WcT, M, D, PW}; pg8::StaticOrder S; S.init(M, D, G, bx);
          mk::EpiGateMul<true> E{P.GATES, D, P.TMP, P.MERGED}; pg8::gemm_phase<mk::EpiGateMul<true>, pg8::StaticOrder, true, true>(lds, g, S, E); }
    } SEAM(4);
    if (IN(5)) { pg8::Gemm g{P.MERGED, P.WoutT, M, D, D}; pg8::StaticOrder S; S.init(M, D, G, bx);
        mk::EpiResF32 E{P.x, P.out}; pg8::gemm_phase<mk::EpiResF32, pg8::StaticOrder, true, true>(lds, g, S, E); } SEAM(5);
    if (IN(6)) { p6_router(P, lds, G, tid, wave, lane); } SEAM(6);
    if (IN(7)) { p7_permute(P, lds, G, tid, wave, lane); } SEAM(7);
    if (IN(8)) { pg8::Gemm g{P.XG, P.WguT, MAXROWS, NE * 2048, D}; mk::MoeOrder S; S.init(P.ctl + CW_TILES, 8, G, bx);
        mk::EpiGlu E{P.b_gu, P.H}; pg8::gemm_phase<mk::EpiGlu, mk::MoeOrder, true, true>(lds, g, S, E); } SEAM(8);
    if (IN(9)) { pg8::Gemm g{P.H, P.WdT, MAXROWS, NE * D, FF}; mk::MoeOrder S; S.init(P.ctl + CW_TILES, 4, G, bx);
        mk::EpiDown E{P.b_d, P.ROWW, P.Y}; pg8::gemm_phase<mk::EpiDown, mk::MoeOrder, true, true>(lds, g, S, E); } SEAM(9);
    if (IN(10)) { p10_combine(P, gw, NGW, lane); } SEAM(10);
    if (IN(11)) {
        { pg8::Gemm g{P.PB, P.WppT, M, D, PLE}; pg8::StaticOrder S; S.init(M, D, G, bx);
          mk::EpiBf E{P.PRJ}; pg8::gemm_phase<mk::EpiBf, pg8::StaticOrder, true, true>(lds, g, S, E); }
        VM_WAIT(); __syncthreads();
        { pg8::Gemm g{P.X2N, P.WpgT, M, D, D}; pg8::StaticOrder S; S.init(M, D, G, bx);
          mk::EpiPle E{P.out, P.PRJ}; pg8::gemm_phase<mk::EpiPle, pg8::StaticOrder, true, true>(lds, g, S, E); }
    } SEAM(11);
    if (IN(12)) { p12_final(P, gw, NGW, lane); }
#undef IN
#undef SEAM
}

extern "C" void kernel_launch(void* const* d_in, const int* in_sizes, int n_in, void* d_out, int out_size, void* d_ws, size_t ws_size, hipStream_t stream) {
    static int grid = 0;
    if (grid == 0) {
        if (n_in != 21 || in_sizes[0] != M * D || out_size != M * D || ws_size < WS_END) { fprintf(stderr, "kernel_launch: unexpected shapes (n_in %d, in0 %d, out %d, ws %zu)\n", n_in, n_in > 0 ? in_sizes[0] : -1, out_size, ws_size); grid = -1; return; }
        int dev = 0, cus = 0;
        if (hipGetDevice(&dev) != hipSuccess || hipDeviceGetAttribute(&cus, hipDeviceAttributeMultiprocessorCount, dev) != hipSuccess) { grid = -1; return; }
        grid = cus;
    }
    if (grid < 0) return;
    (void)hipMemsetAsync((char*)d_ws + WS_CTL, 0, CTL_ZERO_BYTES, stream);
    Args a{};
    for (int i = 0; i < 21; ++i) a.in[i] = (const float*)d_in[i];
    a.out = (float*)d_out; a.ws = (unsigned char*)d_ws;
    if (MK_N_LAUNCHES == 1) { a.ph_lo = 0; a.ph_hi = NPH; hipLaunchKernelGGL(mk_fwd, dim3(grid), dim3(NWAVES * 64), 0, stream, a); }
    else for (int k = 0; k < NPH; ++k) { a.ph_lo = k; a.ph_hi = k + 1; hipLaunchKernelGGL(mk_fwd, dim3(grid), dim3(NWAVES * 64), 0, stream, a); }
}
```

```cpp
#include <hip/hip_runtime.h>
#include <cstdio>
#include <cstdint>
__device__ __forceinline__ int mk_lane_now() { int l; asm volatile("v_mbcnt_lo_u32_b32 %0, -1, 0\n\tv_mbcnt_hi_u32_b32 %0, -1, %0" : "=v"(l)); return l; }
namespace pg8 {
#define PG8_LAS __attribute__((address_space(3)))
typedef unsigned short bf16_t;
typedef short bf16x8 __attribute__((ext_vector_type(8)));
typedef float f32x4 __attribute__((ext_vector_type(4)));
typedef unsigned u32x4 __attribute__((ext_vector_type(4)));
constexpr int BM = 256, BK = 64, HALF = 128, HTB = HALF * BK * 2  , STAGE_BYTES = 8 * HTB, NXCD = 8, WGM = 8;

__host__ __device__ __forceinline__ int lds_byte(int r, int c) { const int st = (r >> 4) * 2 + (c >> 5), rr = r & 15, cc = c & 31, ob = rr * 64 + cc * 2; return st * 1024 + (ob ^ (((ob >> 9) & 1) << 5)); }
__host__ __device__ __forceinline__ void stage_rc(int b, int& R, int& C) { const int st = b / 1024, sb = b % 1024, swz = sb ^ (((sb >> 9) & 1) << 5); R = (st >> 1) * 16 + swz / 64; C = (st & 1) * 32 + (swz % 64) / 2; }
__host__ __device__ __forceinline__ int perm32(int rho) { const int n = rho >> 4, i = rho & 15; return 8 * (i >> 2) + 4 * n + (i & 3); }

struct Unit { int pm, pn; };
struct Gemm { const bf16_t* A; const bf16_t* Bt; int M, N, K, wid; };

struct StaticOrder {
    int nM, nN, nwg, G, c;
    __host__ __device__ void init(int M, int N, int G_, int c_) { nM = M / BM; nN = N / BM; nwg = nM * nN; G = G_; c = c_; }
    __host__ __device__ bool next(int i, Unit& u) const {
        const long L = (long)i * G + c; if (L >= nwg) return false;
        int wgid = (int)L; { const int q = nwg / NXCD, r = nwg % NXCD, xcd = wgid % NXCD, off = wgid / NXCD; wgid = (xcd < r ? xcd * (q + 1) : r * (q + 1) + (xcd - r) * q) + off; }
        const int nig = WGM * nN, gid = wgid / nig, fm = gid * WGM, gsz = (nM - fm) < WGM ? (nM - fm) : WGM;
        u.pm = fm + ((wgid % nig) % gsz); u.pn = (wgid % nig) / gsz; return true;
    }
    __device__ __forceinline__ void a_ready(const Unit&) const {}
    __device__ __forceinline__ void done(const Unit&) const {}
};
__device__ __forceinline__ unsigned cvt_pk_bf16(float lo, float hi) { unsigned r; asm volatile("v_cvt_pk_bf16_f32 %0, %1, %2" : "=v"(r) : "v"(lo), "v"(hi)); return r; }
template <class Epi, class Sched, bool ALIGN_EPI = false, bool SP2 = false>
__device__ __forceinline__ void gemm_phase(PG8_LAS unsigned char* lds, const Gemm g, const Sched& S, const Epi& E) {
    const int wid = g.wid, lane = mk_lane_now(), tid = wid * 64 + lane, wr = wid >> 2, wc = wid & 3, fr = lane & 15, fq = lane >> 4;
    int K_ = g.K; asm volatile("" : "+s"(K_)); const int K = K_, nt = K / BK;
    unsigned voffA[2], voffB[2];
#pragma unroll
    for (int i = 0; i < 2; ++i) { int R, C; stage_rc(tid * 16 + i * 8192, R, C); const int Rb = Epi::PERM ? ((R & ~31) + perm32(R & 31)) : R;
        voffA[i] = (unsigned)(R * K + C) * 2u; voffB[i] = (unsigned)(Rb * K + C) * 2u; }
    const size_t kstep = (size_t)(BK * 2);
    const size_t hstep = (size_t)HALF * K * 2;
    const size_t tstep = 2 * hstep;
    const unsigned ldsw = (unsigned)wid * 1024u;
    const int aoff = lds_byte(wr * 64 + fr, fq * 8), boff = lds_byte(wc * 32 + fr, fq * 8);
#define PG8_SA(b, h) (((b) * 2 + (h)) * HTB)
#define PG8_SB(b, h) ((4 + (b) * 2 + (h)) * HTB)
#define PG8_STAGE(bufoff, gbase, voff) do { _Pragma("unroll") for (int _i = 0; _i < 2; ++_i) \
        __builtin_amdgcn_global_load_lds((const unsigned*)((const char*)(gbase) + (voff)[_i]), (PG8_LAS unsigned*)(lds + (bufoff) + ldsw + _i * 8192), 16, 0, 0); } while (0)
#define PG8_LDA(dst, b, h) do { _Pragma("unroll") for (int m = 0; m < 4; ++m) _Pragma("unroll") for (int k = 0; k < 2; ++k) dst[m][k] = *(const PG8_LAS bf16x8*)(lds + PG8_SA(b, h) + aoff + m * 2048 + k * 1024); } while (0)
#define PG8_LDB(dst, b, h) do { _Pragma("unroll") for (int n = 0; n < 2; ++n) _Pragma("unroll") for (int k = 0; k < 2; ++k) dst[n][k] = *(const PG8_LAS bf16x8*)(lds + PG8_SB(b, h) + boff + n * 2048 + k * 1024); } while (0)
#define PG8_MMA(ai, bj, At, Bt) do { __builtin_amdgcn_s_setprio(1); _Pragma("unroll") for (int m = 0; m < 4; ++m) _Pragma("unroll") for (int n = 0; n < 2; ++n) _Pragma("unroll") for (int k = 0; k < 2; ++k) \
        acc[ai][bj][m][n] = __builtin_amdgcn_mfma_f32_16x16x32_bf16(Bt[n][k], At[m][k], acc[ai][bj][m][n], 0, 0, 0); __builtin_amdgcn_s_setprio(0); } while (0)
#define PG8_WAIT_V(n) asm volatile("s_waitcnt vmcnt(" #n ")" ::: "memory")
#define PG8_WAIT_L(n) asm volatile("s_waitcnt lgkmcnt(" #n ")" ::: "memory")
#define PG8_BAR __builtin_amdgcn_s_barrier()
#define PG8_SCHED __builtin_amdgcn_sched_barrier(0)
    Unit cur, nxt; int ui = 0;
    if (!S.next(0, cur)) return;
    f32x4 acc[2][2][4][2];
#pragma unroll
    for (int a = 0; a < 2; ++a)
#pragma unroll
        for (int b = 0; b < 2; ++b)
#pragma unroll
            for (int m = 0; m < 4; ++m)
#pragma unroll
                for (int n = 0; n < 2; ++n) acc[a][b][m][n] = (f32x4){0.f, 0.f, 0.f, 0.f};
    bf16x8 At[4][2], B0[2][2], B1[2][2];
    const char* cA = (const char*)g.A + (size_t)cur.pm * tstep; const char* cB = (const char*)g.Bt + (size_t)cur.pn * tstep;
    S.a_ready(cur);
    if constexpr (SP2) {
        PG8_STAGE(PG8_SB(0, 0), cB, voffB); PG8_STAGE(PG8_SB(0, 1), cB + hstep, voffB); PG8_STAGE(PG8_SA(0, 0), cA, voffA); PG8_STAGE(PG8_SA(0, 1), cA + hstep, voffA);
        if (wr == 1) PG8_BAR;
        PG8_WAIT_V(2); PG8_BAR;
        PG8_STAGE(PG8_SB(1, 0), cB + kstep, voffB); PG8_STAGE(PG8_SA(1, 0), cA + kstep, voffA); PG8_STAGE(PG8_SB(1, 1), cB + hstep + kstep, voffB);
        PG8_WAIT_V(6); PG8_BAR;
    } else {
        PG8_STAGE(PG8_SB(0, 0), cB, voffB); PG8_STAGE(PG8_SA(0, 0), cA, voffA); PG8_STAGE(PG8_SB(0, 1), cB + hstep, voffB); PG8_STAGE(PG8_SA(0, 1), cA + hstep, voffA);
        if (wr == 1) PG8_BAR;
        PG8_WAIT_V(4); PG8_BAR;
        PG8_STAGE(PG8_SB(1, 0), cB + kstep, voffB); PG8_STAGE(PG8_SA(1, 0), cA + kstep, voffA); PG8_STAGE(PG8_SB(1, 1), cB + hstep + kstep, voffB);
        PG8_WAIT_V(6); PG8_BAR;
    }
    for (;;) {
        const bool has_next = S.next(ui + 1, nxt);
        const char* nA = has_next ? (const char*)g.A + (size_t)nxt.pm * tstep : cA; const char* nB = has_next ? (const char*)g.Bt + (size_t)nxt.pn * tstep : cB;
        for (int t = 0; t < nt; t += 2) {
            const bool last = (t == nt - 2);
            const char* a1 = cA + (size_t)(t + 1) * kstep;
            const char* a2 = last ? nA : cA + (size_t)(t + 2) * kstep; const char* b2 = last ? nB : cB + (size_t)(t + 2) * kstep;
            const char* a3 = a2 + kstep; const char* b3 = b2 + kstep;
            if (last && has_next) S.a_ready(nxt);
            if constexpr (SP2) {
            PG8_LDB(B0, 0, 0); PG8_LDB(B1, 0, 1); PG8_SCHED; PG8_LDA(At, 0, 0); PG8_STAGE(PG8_SA(1, 1), a1 + hstep, voffA);
            PG8_WAIT_V(8); PG8_WAIT_L(0); PG8_BAR; PG8_MMA(0, 0, At, B0); PG8_MMA(0, 1, At, B1); PG8_BAR; PG8_SCHED;
            PG8_LDA(At, 0, 1); PG8_STAGE(PG8_SB(0, 0), b2, voffB); PG8_STAGE(PG8_SB(0, 1), b2 + hstep, voffB); PG8_STAGE(PG8_SA(0, 0), a2, voffA);
            PG8_WAIT_V(8); PG8_WAIT_L(0); PG8_BAR; PG8_MMA(1, 0, At, B0); PG8_MMA(1, 1, At, B1); PG8_BAR; PG8_SCHED;
            PG8_LDB(B0, 1, 0); PG8_LDB(B1, 1, 1); PG8_SCHED; PG8_LDA(At, 1, 0); PG8_STAGE(PG8_SA(0, 1), a2 + hstep, voffA);
            PG8_WAIT_V(8); PG8_WAIT_L(0); PG8_BAR; PG8_MMA(0, 0, At, B0); PG8_MMA(0, 1, At, B1); PG8_BAR; PG8_SCHED;
            PG8_LDA(At, 1, 1); PG8_STAGE(PG8_SB(1, 0), b3, voffB); PG8_STAGE(PG8_SB(1, 1), b3 + hstep, voffB); PG8_STAGE(PG8_SA(1, 0), a3, voffA);
            PG8_WAIT_V(8); PG8_WAIT_L(0); PG8_BAR; PG8_MMA(1, 0, At, B0); PG8_MMA(1, 1, At, B1); PG8_BAR; PG8_SCHED;
            } else {
            PG8_LDB(B0, 0, 0); PG8_SCHED; PG8_LDA(At, 0, 0); PG8_STAGE(PG8_SA(1, 1), a1 + hstep, voffA);
            PG8_WAIT_L(8); PG8_BAR; PG8_WAIT_L(0); PG8_MMA(0, 0, At, B0); PG8_BAR; PG8_SCHED;
            PG8_LDB(B1, 0, 1); PG8_STAGE(PG8_SB(0, 0), b2, voffB);
            PG8_BAR; PG8_WAIT_L(0); PG8_MMA(0, 1, At, B1); PG8_BAR;
            PG8_LDA(At, 0, 1); PG8_STAGE(PG8_SA(0, 0), a2, voffA);
            PG8_BAR; PG8_WAIT_L(0); PG8_MMA(1, 0, At, B0); PG8_BAR; PG8_SCHED;
            PG8_STAGE(PG8_SB(0, 1), b2 + hstep, voffB);
            PG8_WAIT_V(6); PG8_BAR; PG8_MMA(1, 1, At, B1); PG8_BAR;
            PG8_LDB(B0, 1, 0); PG8_SCHED; PG8_LDA(At, 1, 0); PG8_STAGE(PG8_SA(0, 1), a2 + hstep, voffA);
            PG8_WAIT_L(8); PG8_BAR; PG8_WAIT_L(0); PG8_MMA(0, 0, At, B0); PG8_BAR; PG8_SCHED;
            PG8_LDB(B1, 1, 1); PG8_STAGE(PG8_SB(1, 0), b3, voffB);
            PG8_BAR; PG8_WAIT_L(0); PG8_MMA(0, 1, At, B1); PG8_BAR;
            PG8_LDA(At, 1, 1); PG8_STAGE(PG8_SA(1, 0), a3, voffA);
            PG8_BAR; PG8_WAIT_L(0); PG8_MMA(1, 0, At, B0); PG8_BAR; PG8_SCHED;
            PG8_STAGE(PG8_SB(1, 1), b3 + hstep, voffB);
            PG8_WAIT_V(6); PG8_BAR; PG8_MMA(1, 1, At, B1); PG8_BAR;
            }
        }
        if constexpr (ALIGN_EPI) { if (wr == 0) PG8_BAR; }
        if constexpr (!Epi::AFTER_DRAIN) { E(acc, cur, wr, wc, fr, fq); S.done(cur); }
        if (!has_next) break;
#pragma unroll
        for (int a = 0; a < 2; ++a)
#pragma unroll
            for (int b = 0; b < 2; ++b)
#pragma unroll
                for (int m = 0; m < 4; ++m)
#pragma unroll
                    for (int n = 0; n < 2; ++n) acc[a][b][m][n] = (f32x4){0.f, 0.f, 0.f, 0.f};
        cur = nxt; cA = nA; cB = nB; ++ui;
        if constexpr (ALIGN_EPI) { if (wr == 1) PG8_BAR; }
    }
    PG8_WAIT_V(0);
    if constexpr (!ALIGN_EPI) { if (wr == 0) PG8_BAR; }
    PG8_BAR;
    if constexpr (Epi::AFTER_DRAIN) { E.fused(acc, cur, wr, wc, fr, fq, lds, wid, lane); S.done(cur); }
#undef PG8_SA
#undef PG8_SB
#undef PG8_STAGE
#undef PG8_LDA
#undef PG8_LDB
#undef PG8_MMA
#undef PG8_WAIT_V
#undef PG8_WAIT_L
#undef PG8_BAR
#undef PG8_SCHED
}
}
#define GAS __attribute__((address_space(1)))
#define LAS __attribute__((address_space(3)))
#define XB_TMO      128
#define XB_XCNT(j)  (256  + 64 * (j))
#define XB_XSUB(j)  (1280 + 64 * (j))
#define XB_XGEN(j)  (2304 + 64 * (j))
#define XB_TOP      3328
#define XB_TOPGEN   3392
#define XCD_BAR_WORDS 3456
#define XB_SPIN_CAP (1u << 18)

__device__ __forceinline__ unsigned xb_ld(unsigned* p)              { return __hip_atomic_load(p, __ATOMIC_RELAXED, __HIP_MEMORY_SCOPE_AGENT); }
__device__ __forceinline__ unsigned xb_add(unsigned* p, unsigned v) { return __hip_atomic_fetch_add(p, v, __ATOMIC_RELAXED, __HIP_MEMORY_SCOPE_AGENT); }
__device__ __forceinline__ unsigned xb_xcc_id() { return (unsigned)__builtin_amdgcn_s_getreg((3 << 11) | 20) & 0xFu; }
#define XB_SPIN(cond, bar) do { unsigned _sp = 0; while (cond) { __builtin_amdgcn_s_sleep(1); \
    if ((++_sp & 255u) == 0u) { if (xb_ld(&(bar)[XB_TMO])) break; if (_sp > XB_SPIN_CAP) { atomicAdd(&(bar)[XB_TMO], 1u); break; } } } } while (0)

struct XcdBarrier {
    unsigned* bar; unsigned x;
    volatile LAS unsigned* st;
};

__device__ __forceinline__ XcdBarrier xcd_barrier_post(unsigned* bar, volatile LAS unsigned* st) {
    XcdBarrier b; b.bar = bar; b.x = xb_xcc_id(); b.st = st;
    if (threadIdx.x == 0) (void)xb_add(&bar[XB_XCNT(b.x)], 1u);
    return b;
}
__device__ __forceinline__ void xcd_barrier_complete(unsigned* bar, unsigned x, unsigned& nloc, unsigned& nx) {
    const unsigned G = gridDim.x * gridDim.y * gridDim.z;
    unsigned sum, cnt, mine, sp = 0u;
    for (;;) {
        sum = 0u; cnt = 0u; mine = 0u;
#pragma unroll
        for (unsigned j = 0; j < 16; ++j) { const unsigned c = xb_ld(&bar[XB_XCNT(j)]); sum += c; cnt += (c > 0u) ? 1u : 0u; mine = (j == x) ? c : mine; }
        if (sum == G) break;
        __builtin_amdgcn_s_sleep(1);
        if ((++sp & 255u) == 0u) { if (xb_ld(&bar[XB_TMO])) break; if (sp > XB_SPIN_CAP) { atomicAdd(&bar[XB_TMO], 1u); break; } }
    }
    nloc = mine > 0u ? mine : 1u; nx = cnt > 0u ? cnt : 1u;
}

__device__ __forceinline__ void xcd_barrier(const XcdBarrier& b) {
    asm volatile("s_waitcnt vmcnt(0)" ::: "memory");
    __syncthreads();
    if (threadIdx.x == 0) {
        unsigned* bar = b.bar;
        __builtin_amdgcn_s_waitcnt(0);
        unsigned nloc = b.st[0], nx = b.st[1];
        if (nloc == 0u) { xcd_barrier_complete(bar, b.x, nloc, nx); b.st[0] = nloc; b.st[1] = nx; }
        const unsigned old = xb_add(&bar[XB_XSUB(b.x)], 1u);
        const unsigned gen = old / nloc;
        if (old + 1u == (gen + 1u) * nloc) {
            __builtin_amdgcn_fence(__ATOMIC_RELEASE, "agent");
            asm volatile("s_waitcnt vmcnt(0)" ::: "memory");
            const unsigned og = xb_add(&bar[XB_TOP], 1u);
            const unsigned tg = og / nx;
            if (og + 1u == (tg + 1u) * nx) xb_add(&bar[XB_TOPGEN], 1u);
            else XB_SPIN(xb_ld(&bar[XB_TOPGEN]) == tg, bar);
            __builtin_amdgcn_fence(__ATOMIC_ACQUIRE, "agent");
            xb_add(&bar[XB_XGEN(b.x)], 1u);
            asm volatile("s_waitcnt vmcnt(0)" ::: "memory");
        } else {
            XB_SPIN(xb_ld(&bar[XB_XGEN(b.x)]) == gen, bar);
            __builtin_amdgcn_fence(__ATOMIC_ACQUIRE, "agent");
            asm volatile("s_waitcnt vmcnt(0)" ::: "memory");
        }
    }
    __syncthreads();
}

#ifndef MK_ATTN_SIMPLE
#define MK_ATTN_SIMPLE 0
#endif
#ifndef MK_N_LAUNCHES
#define MK_N_LAUNCHES 1
#endif
constexpr int NWAVES = 8;
constexpr int BATCH = 2, SEQ = 8192, D = 1024, M = BATCH * SEQ;
constexpr int NH = 8, HD = 64, AW = 512, PW = 512, INC = 4096;
constexpr int NE = 32, FF = 1024, PLE = 256, MOBA = 256, NBLK = SEQ / MOBA;
constexpr int QP = 2048;
constexpr int MAXROWS = M * 4 + NE * 256;
constexpr float RMS_EPS = 1e-6f;
constexpr float LOG2E = 1.4426950408889634f;
constexpr int NPH = 13;

constexpr size_t MiB = 1u << 20;
constexpr size_t WS_CTL = 0, CTL_ZERO_BYTES = 1 * MiB;
constexpr size_t WS_WIN = 2 * MiB, WS_WA = 10 * MiB, WS_WC = 11 * MiB, WS_WOUT = 12 * MiB, WS_WPG = 14 * MiB, WS_WPP = 16 * MiB;
constexpr size_t WS_RSTD0 = 17 * MiB, WS_KMEAN = WS_RSTD0 + 256 * 1024, WS_TOPI = WS_KMEAN + 256 * 1024, WS_TOPW = WS_TOPI + 256 * 1024;
constexpr size_t WS_INV = 18 * MiB, WS_ROWW = WS_INV + 256 * 1024;
constexpr size_t WS_WGU = 32 * MiB, WS_WD = 160 * MiB, WS_XB = 224 * MiB, WS_PB = 256 * MiB, WS_QKVU = 264 * MiB, WS_GATES = 328 * MiB;
constexpr size_t WS_PIN = 392 * MiB, WS_ATT = 408 * MiB, WS_TMP = 424 * MiB, WS_MERGED = 456 * MiB, WS_X1N = 488 * MiB;
constexpr size_t WS_XG = 520 * MiB, WS_H = 664 * MiB, WS_Y = 808 * MiB, WS_X2N = 952 * MiB, WS_PRJ = 984 * MiB, WS_END = 1016 * MiB;
static_assert(WS_ROWW + (size_t)MAXROWS * 4 <= 19 * MiB && WS_XG + (size_t)MAXROWS * 1024 * 2 <= WS_H && WS_Y + (size_t)MAXROWS * 1024 * 2 <= WS_X2N, "d_ws map");
constexpr int CW_TMO = 0, CW_CODE = 1, CW_BAR = 4096, CW_CNT = 16384, CW_TILES = 32768;
constexpr int LDS_BYTES = 147456, RING_BYTES = 131072, MISC_OFF = RING_BYTES + 320;

typedef unsigned short bf16;
typedef unsigned v4u __attribute__((ext_vector_type(4)));
typedef unsigned v2u __attribute__((ext_vector_type(2)));
typedef float f32x4 __attribute__((ext_vector_type(4)));
typedef GAS unsigned gu32;
#define RLX_AGENT __ATOMIC_RELAXED, __HIP_MEMORY_SCOPE_AGENT
#define LDS_WAIT() asm volatile("s_waitcnt lgkmcnt(0)" ::: "memory")
#define VM_WAIT() asm volatile("s_waitcnt vmcnt(0)" ::: "memory")
__device__ __forceinline__ unsigned f2bf(float f) { unsigned u = __builtin_bit_cast(unsigned, f); return (u + 0x7fffu + ((u >> 16) & 1u)) >> 16; }
__device__ __forceinline__ unsigned pk2(float lo, float hi) { return f2bf(lo) | (f2bf(hi) << 16); }
__device__ __forceinline__ float bflo(unsigned w) { return __uint_as_float(w << 16); }
__device__ __forceinline__ float bfhi(unsigned w) { return __uint_as_float(w & 0xffff0000u); }
__device__ __forceinline__ float bf2f(bf16 h) { return __uint_as_float((unsigned)h << 16); }
__device__ __forceinline__ float sigm(float x) { return __builtin_amdgcn_rcpf(1.0f + __builtin_amdgcn_exp2f(-LOG2E * x)); }
__device__ __forceinline__ float wave_sum(float v) {
#pragma unroll
    for (int o = 1; o < 64; o <<= 1) v += __shfl_xor(v, o);
    return v;
}
__device__ __forceinline__ float wave_max(float v) {
#pragma unroll
    for (int o = 1; o < 64; o <<= 1) v = fmaxf(v, __shfl_xor(v, o));
    return v;
}
__device__ __forceinline__ unsigned ld_ctl(const gu32* p) { return (unsigned)__builtin_amdgcn_readfirstlane((int)__hip_atomic_load(p, RLX_AGENT)); }

namespace mk {
using pg8::Unit; using pg8::BM; using pg8::HALF; using pg8::u32x4; using pg8::cvt_pk_bf16;
struct EpiInProj {
    static constexpr bool PERM = true, AFTER_DRAIN = false;
    bf16* qkvu; bf16* gates; const float* rstd;
    __device__ __forceinline__ void operator()(const f32x4 (&acc)[2][2][4][2], const Unit& u, int wr, int wc, int fr, int fq) const {
        const int row0 = u.pm * BM + wr * 64 + fr; const bool isg = u.pn >= 8;
        bf16* base = isg ? gates : qkvu; const int col0 = (u.pn & 7) * BM + wc * 32 + 8 * fq; const float qs = (u.pn < 2) ? 0.125f * LOG2E : 1.0f;
#pragma unroll
        for (int ai = 0; ai < 2; ++ai)
#pragma unroll
            for (int m = 0; m < 4; ++m) { const int row = row0 + ai * HALF + m * 16; const float rs = rstd[row] * qs; bf16* rowp = base + (size_t)row * QP + col0;
#pragma unroll
                for (int bj = 0; bj < 2; ++bj) { f32x4 v0 = acc[ai][bj][m][0] * rs, v1 = acc[ai][bj][m][1] * rs;
                    if (isg) { v0 = (f32x4){sigm(v0[0]), sigm(v0[1]), sigm(v0[2]), sigm(v0[3])}; v1 = (f32x4){sigm(v1[0]), sigm(v1[1]), sigm(v1[2]), sigm(v1[3])}; }
                    u32x4 w; w.x = cvt_pk_bf16(v0[0], v0[1]); w.y = cvt_pk_bf16(v0[2], v0[3]); w.z = cvt_pk_bf16(v1[0], v1[1]); w.w = cvt_pk_bf16(v1[2], v1[3]);
                    *(u32x4*)(rowp + bj * HALF) = w; } }
    }
};
template <bool ADD> struct EpiGateMul {
    static constexpr bool PERM = true, AFTER_DRAIN = false;
    const bf16* gates; int goff; const bf16* add; bf16* out;
    __device__ __forceinline__ void operator()(const f32x4 (&acc)[2][2][4][2], const Unit& u, int wr, int wc, int fr, int fq) const {
        const int row0 = u.pm * BM + wr * 64 + fr; const int col0 = u.pn * BM + wc * 32 + 8 * fq;
#pragma unroll
        for (int ai = 0; ai < 2; ++ai)
#pragma unroll
            for (int m = 0; m < 4; ++m) { const int row = row0 + ai * HALF + m * 16;
#pragma unroll
                for (int bj = 0; bj < 2; ++bj) { const int c = col0 + bj * HALF;
                    const u32x4 g = *(const u32x4*)(gates + (size_t)row * QP + goff + c);
                    f32x4 v0 = acc[ai][bj][m][0] * (f32x4){bflo(g.x), bfhi(g.x), bflo(g.y), bfhi(g.y)}, v1 = acc[ai][bj][m][1] * (f32x4){bflo(g.z), bfhi(g.z), bflo(g.w), bfhi(g.w)};
                    if (ADD) { const u32x4 a = *(const u32x4*)(add + (size_t)row * D + c); v0 += (f32x4){bflo(a.x), bfhi(a.x), bflo(a.y), bfhi(a.y)}; v1 += (f32x4){bflo(a.z), bfhi(a.z), bflo(a.w), bfhi(a.w)}; }
                    u32x4 w; w.x = cvt_pk_bf16(v0[0], v0[1]); w.y = cvt_pk_bf16(v0[2], v0[3]); w.z = cvt_pk_bf16(v1[0], v1[1]); w.w = cvt_pk_bf16(v1[2], v1[3]);
                    *(u32x4*)(out + (size_t)row * D + c) = w; } }
    }
};
struct EpiResF32 {
    static constexpr bool PERM = false, AFTER_DRAIN = false;
    const float* base; float* out;
    __device__ __forceinline__ void operator()(const f32x4 (&acc)[2][2][4][2], const Unit& u, int wr, int wc, int fr, int fq) const {
        const int row0 = u.pm * BM + wr * 64 + fr; const int col0 = u.pn * BM + wc * 32 + 4 * fq;
#pragma unroll
        for (int ai = 0; ai < 2; ++ai)
#pragma unroll
            for (int m = 0; m < 4; ++m) { const size_t off = (size_t)(row0 + ai * HALF + m * 16) * D + col0;
#pragma unroll
                for (int bj = 0; bj < 2; ++bj)
#pragma unroll
                    for (int n = 0; n < 2; ++n) { const f32x4 b = *(const f32x4*)(base + off + bj * HALF + n * 16); *(f32x4*)(out + off + bj * HALF + n * 16) = b + acc[ai][bj][m][n]; } }
    }
};
__device__ __forceinline__ float glu1(float g, float l) { g = fminf(g, 7.0f); l = fminf(fmaxf(l, -7.0f), 7.0f); return (l + 1.0f) * g * __builtin_amdgcn_rcpf(1.0f + __builtin_amdgcn_exp2f(-1.702f * LOG2E * g)); }
struct EpiGlu {
    static constexpr bool PERM = true, AFTER_DRAIN = false;
    const float* bgu; bf16* H;
    __device__ __forceinline__ void operator()(const f32x4 (&acc)[2][2][4][2], const Unit& u, int wr, int wc, int fr, int fq) const {
        const int e = u.pn >> 3, pnl = u.pn & 7; const int row0 = u.pm * BM + wr * 64 + fr; const int col0 = pnl * BM + wc * 32 + 8 * fq;
        f32x4 bv[2][2];
#pragma unroll
        for (int bj = 0; bj < 2; ++bj)
#pragma unroll
            for (int n = 0; n < 2; ++n) bv[bj][n] = *(const f32x4*)(bgu + (size_t)e * 2048 + col0 + bj * HALF + 4 * n);
#pragma unroll
        for (int ai = 0; ai < 2; ++ai)
#pragma unroll
            for (int m = 0; m < 4; ++m) { const int row = row0 + ai * HALF + m * 16;
#pragma unroll
                for (int bj = 0; bj < 2; ++bj) { const f32x4 v0 = acc[ai][bj][m][0] + bv[bj][0], v1 = acc[ai][bj][m][1] + bv[bj][1];
                    v2u w; w.x = cvt_pk_bf16(glu1(v0[0], v0[1]), glu1(v0[2], v0[3])); w.y = cvt_pk_bf16(glu1(v1[0], v1[1]), glu1(v1[2], v1[3]));
                    *(v2u*)(H + (size_t)row * FF + ((col0 + bj * HALF) >> 1)) = w; } }
    }
};
struct EpiDown {
    static constexpr bool PERM = true, AFTER_DRAIN = false;
    const float* bd; const float* roww; bf16* Y;
    __device__ __forceinline__ void operator()(const f32x4 (&acc)[2][2][4][2], const Unit& u, int wr, int wc, int fr, int fq) const {
        const int e = u.pn >> 2, pnl = u.pn & 3; const int row0 = u.pm * BM + wr * 64 + fr; const int col0 = pnl * BM + wc * 32 + 8 * fq;
        f32x4 bv[2][2];
#pragma unroll
        for (int bj = 0; bj < 2; ++bj)
#pragma unroll
            for (int n = 0; n < 2; ++n) bv[bj][n] = *(const f32x4*)(bd + (size_t)e * D + col0 + bj * HALF + 4 * n);
#pragma unroll
        for (int ai = 0; ai < 2; ++ai)
#pragma unroll
            for (int m = 0; m < 4; ++m) { const int row = row0 + ai * HALF + m * 16; const float rw = roww[row];
#pragma unroll
                for (int bj = 0; bj < 2; ++bj) { const f32x4 v0 = (acc[ai][bj][m][0] + bv[bj][0]) * rw, v1 = (acc[ai][bj][m][1] + bv[bj][1]) * rw;
                    u32x4 w; w.x = cvt_pk_bf16(v0[0], v0[1]); w.y = cvt_pk_bf16(v0[2], v0[3]); w.z = cvt_pk_bf16(v1[0], v1[1]); w.w = cvt_pk_bf16(v1[2], v1[3]);
                    *(u32x4*)(Y + (size_t)row * D + col0 + bj * HALF) = w; } }
    }
};
struct EpiBf {
    static constexpr bool PERM = true, AFTER_DRAIN = false;
    bf16* out;
    __device__ __forceinline__ void operator()(const f32x4 (&acc)[2][2][4][2], const Unit& u, int wr, int wc, int fr, int fq) const {
        const int row0 = u.pm * BM + wr * 64 + fr; const int col0 = u.pn * BM + wc * 32 + 8 * fq;
#pragma unroll
        for (int ai = 0; ai < 2; ++ai)
#pragma unroll
            for (int m = 0; m < 4; ++m) { bf16* rowp = out + (size_t)(row0 + ai * HALF + m * 16) * D + col0;
#pragma unroll
                for (int bj = 0; bj < 2; ++bj) { const f32x4 v0 = acc[ai][bj][m][0], v1 = acc[ai][bj][m][1];
                    u32x4 w; w.x = cvt_pk_bf16(v0[0], v0[1]); w.y = cvt_pk_bf16(v0[2], v0[3]); w.z = cvt_pk_bf16(v1[0], v1[1]); w.w = cvt_pk_bf16(v1[2], v1[3]);
                    *(u32x4*)(rowp + bj * HALF) = w; } }
    }
};
struct EpiPle {
    static constexpr bool PERM = false, AFTER_DRAIN = false;
    float* xio; const bf16* prj;
    __device__ __forceinline__ void operator()(const f32x4 (&acc)[2][2][4][2], const Unit& u, int wr, int wc, int fr, int fq) const {
        const int row0 = u.pm * BM + wr * 64 + fr; const int col0 = u.pn * BM + wc * 32 + 4 * fq;
#pragma unroll
        for (int ai = 0; ai < 2; ++ai)
#pragma unroll
            for (int m = 0; m < 4; ++m) { const size_t off = (size_t)(row0 + ai * HALF + m * 16) * D + col0;
#pragma unroll
                for (int bj = 0; bj < 2; ++bj)
#pragma unroll
                    for (int n = 0; n < 2; ++n) { const size_t c = off + bj * HALF + n * 16; const f32x4 xv = *(const f32x4*)(xio + c); const v2u p = *(const v2u*)(prj + c); const f32x4 a = acc[ai][bj][m][n];
                        *(f32x4*)(xio + c) = xv + (f32x4){sigm(a[0]) * bflo(p.x), sigm(a[1]) * bfhi(p.x), sigm(a[2]) * bflo(p.y), sigm(a[3]) * bfhi(p.y)}; } }
    }
};
struct MoeOrder {
    const gu32* tiles; int TM, NT, G, c;
    __device__ __forceinline__ void init(const gu32* t, int nt, int G_, int c_) { tiles = t; NT = nt; G = G_; c = c_; TM = (int)ld_ctl(t); }
    __device__ __forceinline__ bool next(int i, Unit& u) const {
        const long L = (long)i * G + c; if (L >= (long)TM * NT) return false;
        const int mt = (int)(L / NT), pn = (int)(L % NT);
        u.pm = (int)ld_ctl(tiles + 64 + 2 * mt); u.pn = (int)ld_ctl(tiles + 64 + 2 * mt + 1) * NT + pn; return true;
    }
    __device__ __forceinline__ void a_ready(const Unit&) const {}
    __device__ __forceinline__ void done(const Unit&) const {}
};
}

__device__ __forceinline__ void tr_item(const float* W, int K, int N, const float* ks, bf16* WT, LAS float* scr, int item, int lane) {
    const int nblk = N / 32, kb = item / nblk, nb = item % nblk, k0 = 64 * kb, n0 = 32 * nb;
#pragma unroll 8
    for (int i = 0; i < 32; ++i) { const int kk = 2 * i + (lane >> 5); float v = W[(size_t)(k0 + kk) * N + n0 + (lane & 31)]; if (ks) v *= ks[k0 + kk]; scr[kk * 33 + (lane & 31)] = v; }
    LDS_WAIT(); asm volatile("" ::: "memory");
    const int c = lane & 7;
#pragma unroll
    for (int j = 0; j < 4; ++j) { const int n = (lane >> 3) + 8 * j; const LAS float* s = scr + (8 * c) * 33 + n;
        v4u o; o.x = pk2(s[0 * 33], s[1 * 33]); o.y = pk2(s[2 * 33], s[3 * 33]); o.z = pk2(s[4 * 33], s[5 * 33]); o.w = pk2(s[6 * 33], s[7 * 33]);
        *(GAS v4u*)(WT + (size_t)(n0 + n) * K + k0 + 8 * c) = o; }
    LDS_WAIT(); asm volatile("" ::: "memory");
}

struct Ptrs {
    const float *x, *p, *relb, *g_mix, *w_in, *pool_w, *pool_scale, *w_oa, *w_op, *w_out, *g_ffn, *rw, *rb, *w_gu, *b_gu, *w_d, *b_d, *g_ple, *w_pg, *w_pp, *g_fin;
    float* out; unsigned char* ws; gu32* ctl;
    bf16 *WinT, *WaT, *WcT, *WoutT, *WpgT, *WppT, *WguT, *WdT, *XB, *PB, *QKVU, *GATES, *PIN, *ATT, *TMP, *MERGED, *X1N, *XG, *H, *Y, *X2N, *PRJ, *VT, *ATT2;
    float *RSTD0, *KMEAN, *TOPW, *ROWW; int *TOPI, *INV;
};

__device__ __forceinline__ void p0_prologue(const Ptrs& P, LAS unsigned char* lds, int gw, int NGW, int wave, int lane) {
    LAS float* scr = (LAS float*)(lds + wave * 16384);
    constexpr int I_IN = 16 * 128, I_OA = 8 * 32, I_OUT = 16 * 32, I_PG = 16 * 32, I_PP = 4 * 32, I_GU1 = 16 * 64, I_D1 = 16 * 32;
    constexpr int I_GU = NE * I_GU1, I_D = NE * I_D1, NITEMS = I_IN + I_OA + I_OUT + I_PG + I_PP + I_GU + I_D;
    for (int it = gw; it < NITEMS; it += NGW) {
        int r = it;
        if (r < I_GU) { const int e = r / I_GU1; tr_item(P.w_gu + (size_t)e * D * 2048, D, 2048, P.g_ffn, P.WguT + (size_t)e * 2048 * D, scr, r % I_GU1, lane); continue; } r -= I_GU;
        if (r < I_D) { const int e = r / I_D1; tr_item(P.w_d + (size_t)e * FF * D, FF, D, nullptr, P.WdT + (size_t)e * D * FF, scr, r % I_D1, lane); continue; } r -= I_D;
        if (r < I_IN) { tr_item(P.w_in, D, INC, P.g_mix, P.WinT, scr, r, lane); continue; } r -= I_IN;
        if (r < I_OA) { tr_item(P.w_oa, AW, D, nullptr, P.WaT, scr, r, lane); continue; } r -= I_OA;
        if (r < I_OUT) { tr_item(P.w_out, D, D, nullptr, P.WoutT, scr, r, lane); continue; } r -= I_OUT;
        if (r < I_PG) { tr_item(P.w_pg, D, D, P.g_ple, P.WpgT, scr, r, lane); continue; } r -= I_PG;
        tr_item(P.w_pp, PLE, D, nullptr, P.WppT, scr, r, lane);
    }
    for (int it = gw; it < 512 * 4; it += NGW) {
        const int k = it >> 2, n0 = (it & 3) * 256 + lane * 4, g = k >> 7;
        f32x4 a = {0.f, 0.f, 0.f, 0.f};
        for (int j = 0; j < 128; ++j) { const float s = P.pool_w[(size_t)k * 128 + j] * P.pool_scale[g * 128 + j]; const f32x4 w = *(const f32x4*)(P.w_op + (size_t)(g * 128 + j) * D + n0); a += w * s; }
#pragma unroll
        for (int i = 0; i < 4; ++i) P.WcT[(size_t)(n0 + i) * PW + k] = (bf16)f2bf(a[i]);
    }
    for (int m = gw; m < M; m += NGW) {
        const GAS f32x4* xr = (const GAS f32x4*)(P.x + (size_t)m * D) + lane; f32x4 v[4]; float s = 0.f;
#pragma unroll
        for (int j = 0; j < 4; ++j) { v[j] = xr[64 * j]; s += (v[j].x * v[j].x + v[j].y * v[j].y) + (v[j].z * v[j].z + v[j].w * v[j].w); }
        s = wave_sum(s); if (lane == 0) P.RSTD0[m] = 1.0f / sqrtf(s * (1.0f / D) + RMS_EPS);
        GAS unsigned long long* o8 = (GAS unsigned long long*)(P.XB + (size_t)m * D) + lane;
#pragma unroll
        for (int j = 0; j < 4; ++j) o8[64 * j] = (unsigned long long)pk2(v[j].x, v[j].y) | ((unsigned long long)pk2(v[j].z, v[j].w) << 32);
    }
    for (int i = gw * 64 + lane; i < M * PLE / 8; i += NGW * 64) { const f32x4 a = ((const f32x4*)P.p)[2 * i], b = ((const f32x4*)P.p)[2 * i + 1];
        v4u o; o.x = pk2(a.x, a.y); o.y = pk2(a.z, a.w); o.z = pk2(b.x, b.y); o.w = pk2(b.z, b.w); ((v4u*)P.PB)[i] = o; }
}

__device__ __forceinline__ void p2_kmean_pin(const Ptrs& P, LAS unsigned char* lds, int G, int tid, int gw, int NGW, int lane) {
    for (int it = blockIdx.x; it < BATCH * NBLK * NH; it += G) {
        const int h = it & 7, n = (it >> 3) & 31, b = it >> 8; LAS bf16* T = (LAS bf16*)lds;
#pragma unroll
        for (int i = 0; i < 4; ++i) { const int ch = tid + 512 * i, t = ch >> 3, c8 = ch & 7;
            const v4u w = *(const v4u*)(P.QKVU + (size_t)(b * SEQ + n * MOBA + t) * QP + 2 * AW + h * HD + c8 * 8);
            T[(c8 * 8 + 0) * 264 + t] = (bf16)(w.x & 0xffffu); T[(c8 * 8 + 1) * 264 + t] = (bf16)(w.x >> 16); T[(c8 * 8 + 2) * 264 + t] = (bf16)(w.y & 0xffffu); T[(c8 * 8 + 3) * 264 + t] = (bf16)(w.y >> 16);
            T[(c8 * 8 + 4) * 264 + t] = (bf16)(w.z & 0xffffu); T[(c8 * 8 + 5) * 264 + t] = (bf16)(w.z >> 16); T[(c8 * 8 + 6) * 264 + t] = (bf16)(w.w & 0xffffu); T[(c8 * 8 + 7) * 264 + t] = (bf16)(w.w >> 16); }
        __syncthreads();
#pragma unroll
        for (int i = 0; i < 4; ++i) { const int ch = tid + 512 * i, d = ch >> 5, cc = ch & 31;
            *(v4u*)(P.VT + ((size_t)(b * NH + h) * HD + d) * SEQ + n * MOBA + cc * 8) = *(const LAS v4u*)(T + d * 264 + cc * 8); }
        __syncthreads();
    }
    for (int it = gw; it < BATCH * NBLK * NH; it += NGW) {
        const int h = it & 7, n = (it >> 3) & 31, b = it >> 8;
        const bf16* kp = P.QKVU + (size_t)(b * SEQ + n * MOBA) * QP + AW + h * HD + lane; float s = 0.f;
#pragma unroll 8
        for (int i = 0; i < MOBA; ++i) s += bf2f(kp[(size_t)i * QP]);
        P.KMEAN[((size_t)(b * NH + h) * NBLK + n) * HD + lane] = s * (1.0f / MOBA);
    }
    for (int r = gw; r < M; r += NGW) {
        const int s = r & (SEQ - 1), g = lane >> 4, w = 2 << g; const int cnt = (s + 1 < w) ? s + 1 : w;
        const bf16* up = P.QKVU + (size_t)r * QP + 3 * AW + lane * 8; float a[8];
#pragma unroll
        for (int i = 0; i < 8; ++i) a[i] = 0.f;
        for (int i = 0; i < 16; ++i) if (i < cnt) { const v4u q = *(const v4u*)(up - (size_t)i * QP);
            a[0] += bflo(q.x); a[1] += bfhi(q.x); a[2] += bflo(q.y); a[3] += bfhi(q.y); a[4] += bflo(q.z); a[5] += bfhi(q.z); a[6] += bflo(q.w); a[7] += bfhi(q.w); }
        const v4u q = *(const v4u*)up; const float ic = 1.0f / (float)cnt;
        v4u o; o.x = pk2(a[0] * ic - bflo(q.x), a[1] * ic - bfhi(q.x)); o.y = pk2(a[2] * ic - bflo(q.y), a[3] * ic - bfhi(q.y));
        o.z = pk2(a[4] * ic - bflo(q.z), a[5] * ic - bfhi(q.z)); o.w = pk2(a[6] * ic - bflo(q.w), a[7] * ic - bfhi(q.w));
        *(v4u*)(P.PIN + (size_t)r * PW + lane * 8) = o;
    }
}

__device__ __forceinline__ int t5_bucket(int rel) {
    const int n = rel < 0 ? 0 : rel; if (n < 16) return n;
    int b = 16; b += (n >= 19); b += (n >= 21); b += (n >= 24); b += (n >= 27); b += (n >= 31); b += (n >= 35); b += (n >= 40); b += (n >= 46);
    b += (n >= 52); b += (n >= 59); b += (n >= 67); b += (n >= 77); b += (n >= 87); b += (n >= 99); b += (n >= 113); return b;
}

__device__ __forceinline__ void p3_attn_simple(const Ptrs& P, bf16* dst, int gw, int NGW, int lane) {
    const float NEG = -INFINITY;
    for (int idx = gw; idx < M * NH; idx += NGW) {
        const int t = idx >> 3, h = idx & 7, b = t >> 13, s = t & (SEQ - 1), j = s >> 8;
        const float qv = bf2f(P.QKVU[(size_t)t * QP + h * HD + lane]);
        float qs[64];
#pragma unroll
        for (int d = 0; d < 64; ++d) qs[d] = __builtin_bit_cast(float, __builtin_amdgcn_readlane(__builtin_bit_cast(int, qv), d));
        float g = NEG;
        if (lane < j) { const float* km = P.KMEAN + ((size_t)(b * NH + h) * NBLK + lane) * HD; float a = 0.f;
#pragma unroll
            for (int d = 0; d < 64; ++d) a += qs[d] * km[d];
            g = a; }
        int sel[3];
#pragma unroll
        for (int r = 0; r < 3; ++r) { const float mx = wave_max(g); const unsigned long long bal = __ballot(g == mx); const int ix = __ffsll((long long)bal) - 1; sel[r] = ix; if (lane == ix) g = NEG; }
        const int nvalid = j < 3 ? j : 3;
        float m = NEG, l = 0.f, o = 0.f;
        for (int pc = 0; pc <= nvalid; ++pc) {
            const int n = (pc == 0) ? j : (pc == 1 ? sel[0] : (pc == 2 ? sel[1] : sel[2]));
            const int nch = (pc == 0) ? (((s & 255) >> 6) + 1) : 4;
            for (int c = 0; c < nch; ++c) {
                const int key = n * MOBA + c * 64 + lane, rel = s - key;
                const v4u* kr = (const v4u*)(P.QKVU + (size_t)(b * SEQ + key) * QP + AW + h * HD);
                float sc = 0.f;
#pragma unroll
                for (int i = 0; i < 8; ++i) { const v4u w = kr[i];
                    sc += qs[8 * i] * bflo(w.x) + qs[8 * i + 1] * bfhi(w.x) + qs[8 * i + 2] * bflo(w.y) + qs[8 * i + 3] * bfhi(w.y) + qs[8 * i + 4] * bflo(w.z) + qs[8 * i + 5] * bfhi(w.z) + qs[8 * i + 6] * bflo(w.w) + qs[8 * i + 7] * bfhi(w.w); }
                sc += P.relb[t5_bucket(rel) * NH + h] * LOG2E; if (rel < 0) sc = NEG;
                const float cm = wave_max(sc), mn = fmaxf(m, cm);
                const float pr = __builtin_amdgcn_exp2f(sc - mn), al = __builtin_amdgcn_exp2f(m - mn);
                l = l * al + wave_sum(pr); o *= al; m = mn;
                const bf16* vb = P.QKVU + (size_t)(b * SEQ + n * MOBA + c * 64) * QP + 2 * AW + h * HD + lane;
#pragma unroll 16
                for (int kk = 0; kk < 64; ++kk) o += __builtin_bit_cast(float, __builtin_amdgcn_readlane(__builtin_bit_cast(int, pr), kk)) * bf2f(vb[(size_t)kk * QP]);
            }
        }
        dst[(size_t)t * AW + h * HD + lane] = (bf16)f2bf(o / l);
    }
}

__device__ __forceinline__ void p6_router(const Ptrs& P, LAS unsigned char* lds, int G, int tid, int wave, int lane) {
    LAS float* XS = (LAS float*)lds;
    LAS float* PART = (LAS float*)(lds + 65536);
    LAS float* LG = (LAS float*)(lds + 98304);
    LAS float* RS = (LAS float*)(lds + 100352);
    LAS unsigned* HIST = (LAS unsigned*)(lds + 100480);
    const int e = lane & 31, kq = lane >> 5, kbase = 128 * wave + 64 * kq;
    float wreg[64];
#pragma unroll
    for (int i = 0; i < 64; ++i) wreg[i] = P.rw[(size_t)(kbase + i) * NE + e] * P.g_ffn[kbase + i];
    for (int chunk = blockIdx.x; chunk < M / 64; chunk += G) {
        if (tid < 32) HIST[tid] = 0u;
        for (int bt = 0; bt < 4; ++bt) {
            __syncthreads();
#pragma unroll
            for (int tt = 0; tt < 2; ++tt) { const int tl = wave * 2 + tt, row = chunk * 64 + bt * 16 + tl;
                const GAS f32x4* xr = (const GAS f32x4*)(P.out + (size_t)row * D) + lane; f32x4 v[4]; float s = 0.f;
#pragma unroll
                for (int j = 0; j < 4; ++j) { v[j] = xr[64 * j]; s += (v[j].x * v[j].x + v[j].y * v[j].y) + (v[j].z * v[j].z + v[j].w * v[j].w); }
                s = wave_sum(s); const float rs = 1.0f / sqrtf(s * (1.0f / D) + RMS_EPS);
                GAS unsigned long long* o8 = (GAS unsigned long long*)(P.X1N + (size_t)row * D) + lane;
#pragma unroll
                for (int j = 0; j < 4; ++j) { *(LAS f32x4*)(XS + tl * 1024 + 4 * lane + 256 * j) = v[j];
                    o8[64 * j] = (unsigned long long)pk2(v[j].x * rs, v[j].y * rs) | ((unsigned long long)pk2(v[j].z * rs, v[j].w * rs) << 32); }
                if (lane == 0) RS[tl] = rs; }
            __syncthreads();
            for (int tl = 0; tl < 16; ++tl) { float a = 0.f;
#pragma unroll
                for (int i4 = 0; i4 < 16; ++i4) { const f32x4 xv = *(const LAS f32x4*)(XS + tl * 1024 + kbase + 4 * i4);
                    a += xv.x * wreg[4 * i4] + xv.y * wreg[4 * i4 + 1] + xv.z * wreg[4 * i4 + 2] + xv.w * wreg[4 * i4 + 3]; }
                PART[(tl * 16 + wave * 2 + kq) * 32 + e] = a; }
            __syncthreads();
            { const int tl = tid >> 5, ee = tid & 31; float a = 0.f;
#pragma unroll
                for (int q = 0; q < 16; ++q) a += PART[(tl * 16 + q) * 32 + ee];
                LG[tl * 32 + ee] = a * RS[tl] + P.rb[ee]; }
            __syncthreads();
            { const int tl = wave * 2 + kq, row = chunk * 64 + bt * 16 + tl; float v = LG[tl * 32 + e]; float tv[4]; int ti[4];
#pragma unroll
                for (int r = 0; r < 4; ++r) { float mx = v;
#pragma unroll
                    for (int o = 1; o < 32; o <<= 1) mx = fmaxf(mx, __shfl_xor(mx, o));
                    const unsigned long long bal = __ballot(v == mx); const unsigned hm = kq ? (unsigned)(bal >> 32) : (unsigned)bal; const int ix = __ffs((int)hm) - 1;
                    tv[r] = mx; ti[r] = ix; if (e == ix) v = -INFINITY; }
                const float e1 = __builtin_amdgcn_exp2f((tv[1] - tv[0]) * LOG2E), e2 = __builtin_amdgcn_exp2f((tv[2] - tv[0]) * LOG2E), e3 = __builtin_amdgcn_exp2f((tv[3] - tv[0]) * LOG2E);
                const float inv = 1.0f / (1.0f + e1 + e2 + e3);
                if (e == 0) { P.TOPI[row * 4 + 0] = ti[0]; P.TOPI[row * 4 + 1] = ti[1]; P.TOPI[row * 4 + 2] = ti[2]; P.TOPI[row * 4 + 3] = ti[3];
                    P.TOPW[row * 4 + 0] = inv; P.TOPW[row * 4 + 1] = e1 * inv; P.TOPW[row * 4 + 2] = e2 * inv; P.TOPW[row * 4 + 3] = e3 * inv;
                    __hip_atomic_fetch_add(HIST + ti[0], 1u, __ATOMIC_RELAXED, __HIP_MEMORY_SCOPE_WORKGROUP); __hip_atomic_fetch_add(HIST + ti[1], 1u, __ATOMIC_RELAXED, __HIP_MEMORY_SCOPE_WORKGROUP); __hip_atomic_fetch_add(HIST + ti[2], 1u, __ATOMIC_RELAXED, __HIP_MEMORY_SCOPE_WORKGROUP); __hip_atomic_fetch_add(HIST + ti[3], 1u, __ATOMIC_RELAXED, __HIP_MEMORY_SCOPE_WORKGROUP); } }
        }
        __syncthreads();
        if (tid < 32) P.ctl[CW_CNT + chunk * 32 + tid] = HIST[tid];
        __syncthreads();
    }
}

__device__ __forceinline__ void p7_permute(const Ptrs& P, LAS unsigned char* lds, int G, int tid, int wave, int lane) {
    LAS unsigned* SUMT = (LAS unsigned*)lds;
    LAS unsigned* SUMB = SUMT + 512;
    LAS unsigned* TOT = SUMB + 512;
    LAS unsigned* BASEP = TOT + 32; LAS unsigned* NTM = BASEP + 32; LAS unsigned* PST = NTM + 32;
    LAS unsigned* ES = PST + 32;
    LAS unsigned* POS = ES + 256;
    for (int chunk = blockIdx.x; chunk < M / 64; chunk += G) {
        { const int e = tid & 31, part = tid >> 5; unsigned st = 0u, sb = 0u;
            for (int c = 16 * part; c < 16 * part + 16; ++c) { const unsigned v = __hip_atomic_load(P.ctl + CW_CNT + c * 32 + e, RLX_AGENT); st += v; if (c < chunk) sb += v; }
            SUMT[part * 32 + e] = st; SUMB[part * 32 + e] = sb; }
        __syncthreads();
        if (tid < 32) { unsigned st = 0u, sb = 0u;
            for (int q = 0; q < 16; ++q) { st += SUMT[q * 32 + tid]; sb += SUMB[q * 32 + tid]; }
            TOT[tid] = st; BASEP[tid] = sb; NTM[tid] = (st + 255u) >> 8; }
        __syncthreads();
        if (tid < 32) { unsigned ps = 0u; for (int q = 0; q < tid; ++q) ps += NTM[q]; PST[tid] = ps * 256u; }
        if (tid < 256) ES[tid] = (unsigned)P.TOPI[(chunk * 64 + (tid >> 2)) * 4 + (tid & 3)];
        __syncthreads();
        if (tid < 256) { const unsigned e = ES[tid]; unsigned rank = 0u;
            for (int a = 0; a < tid; ++a) rank += (ES[a] == e) ? 1u : 0u;
            const unsigned pos = PST[e] + BASEP[e] + rank; const int ta = (chunk * 64 + (tid >> 2)) * 4 + (tid & 3);
            P.INV[ta] = (int)pos; P.ROWW[pos] = P.TOPW[ta]; POS[tid] = pos; }
        __syncthreads();
        for (int a = wave * 32; a < wave * 32 + 32; ++a) { const int tok = chunk * 64 + (a >> 2); const unsigned pos = POS[a];
            const v4u* src = (const v4u*)(P.X1N + (size_t)tok * D); v4u* dst = (v4u*)(P.XG + (size_t)pos * D);
            const v4u a0 = src[lane], a1 = src[lane + 64]; dst[lane] = a0; dst[lane + 64] = a1; }
        if (chunk < NE) { const unsigned r0 = PST[chunk] + TOT[chunk], r1 = PST[chunk] + NTM[chunk] * 256u;
            for (unsigned r = r0 + wave; r < r1; r += NWAVES) { v4u* dst = (v4u*)(P.XG + (size_t)r * D); const v4u z = {0u, 0u, 0u, 0u}; dst[lane] = z; dst[lane + 64] = z; if (lane == 0) P.ROWW[r] = 0.f; } }
        if (chunk == 0) { if (tid < 32) { const unsigned pm0 = PST[tid] >> 8; for (unsigned k = 0; k < NTM[tid]; ++k) { P.ctl[CW_TILES + 64 + 2 * (pm0 + k)] = pm0 + k; P.ctl[CW_TILES + 64 + 2 * (pm0 + k) + 1] = (unsigned)tid; } }
            if (tid == 0) P.ctl[CW_TILES] = (PST[31] >> 8) + NTM[31]; }
        __syncthreads();
    }
}

__device__ __forceinline__ void p10_combine(const Ptrs& P, int gw, int NGW, int lane) {
    for (int m = gw; m < M; m += NGW) {
        GAS f32x4* xr = (GAS f32x4*)(P.out + (size_t)m * D) + lane; f32x4 v[4];
#pragma unroll
        for (int j = 0; j < 4; ++j) v[j] = xr[64 * j];
#pragma unroll
        for (int k = 0; k < 4; ++k) { const int pos = P.INV[m * 4 + k]; const v2u* yr = (const v2u*)(P.Y + (size_t)pos * D) + lane;
#pragma unroll
            for (int j = 0; j < 4; ++j) { const v2u y = yr[64 * j]; v[j] += (f32x4){bflo(y.x), bfhi(y.x), bflo(y.y), bfhi(y.y)}; } }
        float s = 0.f;
#pragma unroll
        for (int j = 0; j < 4; ++j) s += (v[j].x * v[j].x + v[j].y * v[j].y) + (v[j].z * v[j].z + v[j].w * v[j].w);
        s = wave_sum(s); const float rs = 1.0f / sqrtf(s * (1.0f / D) + RMS_EPS);
        GAS unsigned long long* o8 = (GAS unsigned long long*)(P.X2N + (size_t)m * D) + lane;
#pragma unroll
        for (int j = 0; j < 4; ++j) { xr[64 * j] = v[j]; o8[64 * j] = (unsigned long long)pk2(v[j].x * rs, v[j].y * rs) | ((unsigned long long)pk2(v[j].z * rs, v[j].w * rs) << 32); }
    }
}

__device__ __forceinline__ void p12_final(const Ptrs& P, int gw, int NGW, int lane) {
    const GAS f32x4* gr = (const GAS f32x4*)P.g_fin + lane; f32x4 gv[4];
#pragma unroll
    for (int j = 0; j < 4; ++j) gv[j] = gr[64 * j];
    for (int m = gw; m < M; m += NGW) {
        GAS f32x4* xr = (GAS f32x4*)(P.out + (size_t)m * D) + lane; f32x4 v[4]; float s = 0.f;
#pragma unroll
        for (int j = 0; j < 4; ++j) { v[j] = xr[64 * j]; s += (v[j].x * v[j].x + v[j].y * v[j].y) + (v[j].z * v[j].z + v[j].w * v[j].w); }
        s = wave_sum(s); const float rs = 1.0f / sqrtf(s * (1.0f / D) + RMS_EPS);
#pragma unroll
        for (int j = 0; j < 4; ++j) xr[64 * j] = v[j] * rs * gv[j];
    }
}


namespace moba {
typedef short bf16x8 __attribute__((ext_vector_type(8)));
typedef float f32x16 __attribute__((ext_vector_type(16)));
typedef float f32x2_t __attribute__((ext_vector_type(2))); typedef __bf16 bf16x2_t __attribute__((ext_vector_type(2)));
constexpr int SO_ROW = 136;
constexpr int A_SO = 0, A_LSE = 3 * 256 * SO_ROW;
constexpr int A_LUT = A_LSE + 3072;
constexpr int A_PAIR = A_LUT + 3072;
constexpr int A_CNT = A_PAIR + 3072;
constexpr int A_OFF = A_CNT + 128;
constexpr int A_GRP = A_OFF + 128;
constexpr int A_NG = A_GRP + 1024;
constexpr int A_END = A_NG + 16;
static_assert(A_END <= RING_BYTES, "attention LDS");
constexpr float C2 = 0.125f * LOG2E;

__device__ __forceinline__ unsigned cvtpk(float lo, float hi) { f32x2_t v = {lo, hi}; bf16x2_t b = __builtin_convertvector(v, bf16x2_t); return __builtin_bit_cast(unsigned, b); }
__device__ __forceinline__ float xhalf_max(float m) { auto rr = __builtin_amdgcn_permlane32_swap(__float_as_uint(m), __float_as_uint(m), false, false); return fmaxf(__uint_as_float(rr[0]), __uint_as_float(rr[1])); }
__device__ __forceinline__ float xhalf_sum(float m) { auto rr = __builtin_amdgcn_permlane32_swap(__float_as_uint(m), __float_as_uint(m), false, false); return __uint_as_float(rr[0]) + __uint_as_float(rr[1]); }
#define MOBA_MFMA(a, b, c) __builtin_amdgcn_mfma_f32_32x32x16_bf16((a), (b), (c), 0, 0, 0)

struct FState { float m, l; f32x16 o0, o1; };

template <bool LUTMODE>
__device__ __forceinline__ void subtile(FState& st, const bf16x8 (&qr)[4], const bf16* kp, const bf16* vp, float cb, const LAS float* lut, int lidx) {
    bf16x8 kf[2][4], vf[2][2][2];
#pragma unroll
    for (int hf = 0; hf < 2; ++hf)
#pragma unroll
        for (int d0 = 0; d0 < 4; ++d0) kf[hf][d0] = *(const bf16x8*)(kp + (size_t)hf * 32 * QP + d0 * 16);
#pragma unroll
    for (int hf = 0; hf < 2; ++hf)
#pragma unroll
        for (int s = 0; s < 2; ++s)
#pragma unroll
            for (int db = 0; db < 2; ++db) vf[hf][s][db] = *(const bf16x8*)(vp + (size_t)db * 32 * SEQ + hf * 32 + s * 16);
    f32x16 p[2];
#pragma unroll
    for (int hf = 0; hf < 2; ++hf) {
#pragma unroll
        for (int r = 0; r < 16; ++r) p[hf][r] = LUTMODE ? 0.f : cb;
#pragma unroll
        for (int d0 = 0; d0 < 4; ++d0) p[hf] = MOBA_MFMA(kf[hf][d0], qr[d0], p[hf]);
    }
    if (LUTMODE) {
#pragma unroll
        for (int hf = 0; hf < 2; ++hf)
#pragma unroll
            for (int r = 0; r < 16; ++r) p[hf][r] += lut[lidx - (hf * 32 + (r & 7) + 16 * (r >> 3))];
    }
    float mx = fmaxf(p[0][0], p[1][0]);
#pragma unroll
    for (int r = 1; r < 16; ++r) mx = fmaxf(mx, fmaxf(p[0][r], p[1][r]));
    mx = xhalf_max(mx);
    const float mn = fmaxf(st.m, mx), al = __builtin_amdgcn_exp2f(st.m - mn);
    float rs = 0.f;
#pragma unroll
    for (int hf = 0; hf < 2; ++hf)
#pragma unroll
        for (int r = 0; r < 16; ++r) { p[hf][r] = __builtin_amdgcn_exp2f(p[hf][r] - mn); rs += p[hf][r]; }
    st.l = st.l * al + rs; st.m = mn;
#pragma unroll
    for (int r = 0; r < 16; ++r) { st.o0[r] *= al; st.o1[r] *= al; }
#pragma unroll
    for (int hf = 0; hf < 2; ++hf)
#pragma unroll
        for (int s = 0; s < 2; ++s) {
            v4u w; w.x = cvtpk(p[hf][8 * s], p[hf][8 * s + 1]); w.y = cvtpk(p[hf][8 * s + 2], p[hf][8 * s + 3]); w.z = cvtpk(p[hf][8 * s + 4], p[hf][8 * s + 5]); w.w = cvtpk(p[hf][8 * s + 6], p[hf][8 * s + 7]);
            const bf16x8 pb = __builtin_bit_cast(bf16x8, w);
            st.o0 = MOBA_MFMA(vf[hf][s][0], pb, st.o0); st.o1 = MOBA_MFMA(vf[hf][s][1], pb, st.o1);
        }
}

__device__ __forceinline__ void attn_unit(const Ptrs& P, LAS unsigned char* lds, int b, int h, int j, int tid, int wave, int lane) {
    const int c = lane & 31, hi = lane >> 5;
    LAS float* LSE = (LAS float*)(lds + A_LSE); LAS float* LUT = (LAS float*)(lds + A_LUT); LAS unsigned* PAIR = (LAS unsigned*)(lds + A_PAIR);
    LAS unsigned* CNT = (LAS unsigned*)(lds + A_CNT); LAS unsigned* OFF = (LAS unsigned*)(lds + A_OFF); LAS unsigned* GRP = (LAS unsigned*)(lds + A_GRP); LAS unsigned* NGW_ = (LAS unsigned*)(lds + A_NG);
    const size_t row0 = (size_t)b * SEQ;
    const bf16* Qb = P.QKVU + (row0 + (size_t)j * MOBA) * QP + h * HD;
    const bf16* Kb = P.QKVU + row0 * QP + AW + h * HD;
    const bf16* Vt = P.VT + (size_t)(b * NH + h) * HD * SEQ;
    const int kap = (c & 0x13) | ((c & 4) << 1) | ((c & 8) >> 1);
    const float NEG = -INFINITY;
    if (tid < 32) CNT[tid] = 0u;
    if (tid == 32) { NGW_[0] = 0u; NGW_[1] = 0u; }
    for (int i = tid; i < 768; i += NWAVES * 64) { const int rel = i - 256; LUT[i] = rel < 0 ? NEG : P.relb[t5_bucket(rel) * NH + h] * LOG2E; }
    __syncthreads();
    const float cb31 = LUT[256 + 200];
    const int nvalid = j < 3 ? j : 3;
    const int q_own = 32 * wave + c;
    bf16x8 qo[4];
#pragma unroll
    for (int d0 = 0; d0 < 4; ++d0) qo[d0] = *(const bf16x8*)(Qb + (size_t)q_own * QP + d0 * 16 + hi * 8);
    int sel0 = 0, sel1 = 0, sel2 = 0; unsigned rk0 = 0, rk1 = 0, rk2 = 0;
    if (j > 0) {
        f32x16 g;
#pragma unroll
        for (int r = 0; r < 16; ++r) g[r] = 0.f;
        const float* km = P.KMEAN + ((size_t)(b * NH + h) * NBLK + c) * HD + hi * 8;
#pragma unroll
        for (int d0 = 0; d0 < 4; ++d0) { const f32x4 a = *(const f32x4*)(km + d0 * 16), bq = *(const f32x4*)(km + d0 * 16 + 4);
            const float v[8] = {a.x, a.y, a.z, a.w, bq.x, bq.y, bq.z, bq.w}; unsigned wh[4], wl[4];
#pragma unroll
            for (int i = 0; i < 4; ++i) { const unsigned h0 = f2bf(v[2 * i]), h1 = f2bf(v[2 * i + 1]); wh[i] = h0 | (h1 << 16);
                wl[i] = f2bf(v[2 * i] - __uint_as_float(h0 << 16)) | (f2bf(v[2 * i + 1] - __uint_as_float(h1 << 16)) << 16); }
            const bf16x8 kh = __builtin_bit_cast(bf16x8, (v4u){wh[0], wh[1], wh[2], wh[3]}), kl = __builtin_bit_cast(bf16x8, (v4u){wl[0], wl[1], wl[2], wl[3]});
            g = MOBA_MFMA(kh, qo[d0], g); g = MOBA_MFMA(kl, qo[d0], g); }
#pragma unroll
        for (int r = 0; r < 16; ++r) { const int n = (r & 3) + 8 * (r >> 2) + 4 * hi; if (n >= j) g[r] = NEG; }
#pragma unroll
        for (int s = 0; s < 3; ++s) {
            float bv = g[0]; int bi = 4 * hi;
#pragma unroll
            for (int r = 1; r < 16; ++r) { const int n = (r & 3) + 8 * (r >> 2) + 4 * hi; if (g[r] > bv) { bv = g[r]; bi = n; } }
            const float pv = __shfl_xor(bv, 32); const int pi = __shfl_xor(bi, 32);
            if (pv > bv || (pv == bv && pi < bi)) { bv = pv; bi = pi; }
#pragma unroll
            for (int r = 0; r < 16; ++r) { const int n = (r & 3) + 8 * (r >> 2) + 4 * hi; if (n == bi) g[r] = NEG; }
            if (s == 0) sel0 = bi; else if (s == 1) sel1 = bi; else sel2 = bi;
        }
        if (hi == 0) {
            if (nvalid > 0) rk0 = __hip_atomic_fetch_add(CNT + sel0, 1u, __ATOMIC_RELAXED, __HIP_MEMORY_SCOPE_WORKGROUP);
            if (nvalid > 1) rk1 = __hip_atomic_fetch_add(CNT + sel1, 1u, __ATOMIC_RELAXED, __HIP_MEMORY_SCOPE_WORKGROUP);
            if (nvalid > 2) rk2 = __hip_atomic_fetch_add(CNT + sel2, 1u, __ATOMIC_RELAXED, __HIP_MEMORY_SCOPE_WORKGROUP);
        }
    }
    __syncthreads();
    if (wave == 0) {
        const unsigned cn = (lane < 32 && lane < j) ? CNT[lane & 31] : 0u; const unsigned ng = (cn + 31u) >> 5;
        unsigned po = cn, pg = ng;
#pragma unroll
        for (int o = 1; o < 32; o <<= 1) { const unsigned a = __shfl_up(po, o), bq = __shfl_up(pg, o); if ((lane & 31) >= o) { po += a; pg += bq; } }
        if (lane < 32) { OFF[lane] = po - cn; const unsigned g0 = pg - ng;
            for (unsigned k = 0; k < ng; ++k) { GRP[(g0 + k) * 4] = (unsigned)lane; GRP[(g0 + k) * 4 + 1] = po - cn + 32u * k; GRP[(g0 + k) * 4 + 2] = (cn - 32u * k) < 32u ? (cn - 32u * k) : 32u; }
            if (lane == 31) NGW_[0] = pg; }
    }
    __syncthreads();
    if (hi == 0 && j > 0) {
        if (nvalid > 0) PAIR[OFF[sel0] + rk0] = (unsigned)q_own;
        if (nvalid > 1) PAIR[OFF[sel1] + rk1] = (unsigned)q_own | (1u << 8);
        if (nvalid > 2) PAIR[OFF[sel2] + rk2] = (unsigned)q_own | (2u << 8);
    }
    __syncthreads();
    const unsigned NG = NGW_[0];
    for (;;) {
        unsigned gi = 0u; if (lane == 0) gi = __hip_atomic_fetch_add(NGW_ + 1, 1u, __ATOMIC_RELAXED, __HIP_MEMORY_SCOPE_WORKGROUP);
        gi = (unsigned)__builtin_amdgcn_readfirstlane((int)gi);
        if (gi >= NG) break;
        const int n = (int)GRP[gi * 4], first = (int)GRP[gi * 4 + 1], cnt = (int)GRP[gi * 4 + 2];
        const unsigned pr = PAIR[first + (c < cnt ? c : 0)]; const int q = (int)(pr & 255u), s = (int)(pr >> 8);
        bf16x8 qr[4];
#pragma unroll
        for (int d0 = 0; d0 < 4; ++d0) qr[d0] = *(const bf16x8*)(Qb + (size_t)q * QP + d0 * 16 + hi * 8);
        FState st; st.m = NEG; st.l = 0.f;
#pragma unroll
        for (int r = 0; r < 16; ++r) { st.o0[r] = 0.f; st.o1[r] = 0.f; }
        const bf16* kp = Kb + (size_t)(n * MOBA + kap) * QP + hi * 8; const bf16* vp = Vt + (size_t)c * SEQ + n * MOBA + hi * 8;
        if (n == j - 1) { const int lidx = (j * MOBA + q) - n * MOBA + 256 - 8 * hi;
            for (int kt = 0; kt < 4; ++kt) subtile<true>(st, qr, kp + (size_t)kt * 64 * QP, vp + kt * 64, 0.f, LUT, lidx - kt * 64);
        } else {
            for (int kt = 0; kt < 4; ++kt) subtile<false>(st, qr, kp + (size_t)kt * 64 * QP, vp + kt * 64, cb31, LUT, 0);
        }
        const float lt = xhalf_sum(st.l), il = 1.0f / lt;
        if (c < cnt) {
            LAS unsigned char* so = lds + A_SO + (s * 256 + q) * SO_ROW;
#pragma unroll
            for (int a = 0; a < 4; ++a) {
                v2u w0; w0.x = cvtpk(st.o0[4 * a] * il, st.o0[4 * a + 1] * il); w0.y = cvtpk(st.o0[4 * a + 2] * il, st.o0[4 * a + 3] * il);
                v2u w1; w1.x = cvtpk(st.o1[4 * a] * il, st.o1[4 * a + 1] * il); w1.y = cvtpk(st.o1[4 * a + 2] * il, st.o1[4 * a + 3] * il);
                *(LAS v2u*)(so + (8 * a + 4 * hi) * 2) = w0; *(LAS v2u*)(so + (32 + 8 * a + 4 * hi) * 2) = w1; }
            if (hi == 0) LSE[s * 256 + q] = st.m + __builtin_amdgcn_logf(lt);
        }
    }
    __syncthreads();
    {
        FState st; st.m = NEG; st.l = 0.f;
#pragma unroll
        for (int r = 0; r < 16; ++r) { st.o0[r] = 0.f; st.o1[r] = 0.f; }
        const bf16* kp = Kb + (size_t)(j * MOBA + kap) * QP + hi * 8; const bf16* vp = Vt + (size_t)c * SEQ + j * MOBA + hi * 8;
        const int lidx = q_own + 256 - 8 * hi; const int nkt = (wave >> 1) + 1;
        for (int kt = 0; kt < nkt; ++kt) subtile<true>(st, qo, kp + (size_t)kt * 64 * QP, vp + kt * 64, 0.f, LUT, lidx - kt * 64);
        const float lt = xhalf_sum(st.l); const float lse_own = st.m + __builtin_amdgcn_logf(lt);
        float ls0 = NEG, ls1 = NEG, ls2 = NEG;
        if (nvalid > 0) ls0 = LSE[q_own]; if (nvalid > 1) ls1 = LSE[256 + q_own]; if (nvalid > 2) ls2 = LSE[512 + q_own];
        const float Mx = fmaxf(fmaxf(lse_own, ls0), fmaxf(ls1, ls2));
        const float w0 = __builtin_amdgcn_exp2f(ls0 - Mx), w1 = __builtin_amdgcn_exp2f(ls1 - Mx), w2 = __builtin_amdgcn_exp2f(ls2 - Mx), wo = __builtin_amdgcn_exp2f(st.m - Mx);
        const float inv = 1.0f / (wo * lt + w0 + w1 + w2);
        bf16* op = P.ATT + (row0 + (size_t)j * MOBA + q_own) * AW + h * HD;
#pragma unroll
        for (int a = 0; a < 4; ++a)
#pragma unroll
            for (int db = 0; db < 2; ++db) {
                const int d = 32 * db + 8 * a + 4 * hi; float v[4];
#pragma unroll
                for (int i = 0; i < 4; ++i) v[i] = (db ? st.o1[4 * a + i] : st.o0[4 * a + i]) * wo;
                if (nvalid > 0) { const v2u t = *(const LAS v2u*)(lds + A_SO + (0 * 256 + q_own) * SO_ROW + d * 2); v[0] += w0 * bflo(t.x); v[1] += w0 * bfhi(t.x); v[2] += w0 * bflo(t.y); v[3] += w0 * bfhi(t.y); }
                if (nvalid > 1) { const v2u t = *(const LAS v2u*)(lds + A_SO + (1 * 256 + q_own) * SO_ROW + d * 2); v[0] += w1 * bflo(t.x); v[1] += w1 * bfhi(t.x); v[2] += w1 * bflo(t.y); v[3] += w1 * bfhi(t.y); }
                if (nvalid > 2) { const v2u t = *(const LAS v2u*)(lds + A_SO + (2 * 256 + q_own) * SO_ROW + d * 2); v[0] += w2 * bflo(t.x); v[1] += w2 * bfhi(t.x); v[2] += w2 * bflo(t.y); v[3] += w2 * bfhi(t.y); }
                v2u o; o.x = cvtpk(v[0] * inv, v[1] * inv); o.y = cvtpk(v[2] * inv, v[3] * inv);
                *(v2u*)(op + d) = o; }
    }
    __syncthreads();
}
__device__ __forceinline__ void attn_phase(const Ptrs& P, LAS unsigned char* lds, int vcu, int G, int tid, int wave, int lane) {
    for (int u = vcu; u < BATCH * NH * NBLK; u += G) {
        const int bh = (u & 255) >> 4, j = (u < 256) ? 31 - (u & 15) : (u & 15);
        attn_unit(P, lds, bh >> 3, bh & 7, j, tid, wave, lane);
    }
}
#undef MOBA_MFMA
}

struct Args { const float* in[21]; float* out; unsigned char* ws; int ph_lo, ph_hi; };
__global__ void __launch_bounds__(NWAVES * 64, 2) mk_fwd(Args args) {
    __shared__ __attribute__((aligned(16))) unsigned char lds_raw[LDS_BYTES];
    LAS unsigned char* lds = (LAS unsigned char*)lds_raw;
    volatile LAS unsigned* MISC = (volatile LAS unsigned*)(lds + MISC_OFF);
    const int wave = __builtin_amdgcn_readfirstlane((int)threadIdx.x >> 6);
#define LANE_TID const int lane = mk_lane_now(), tid = wave * 64 + lane; (void)tid; (void)lane
    const int G = gridDim.x; const int bx = blockIdx.x; const int vcu = (G % 8 == 0) ? (bx % 8) * (G / 8) + bx / 8 : bx;
    const int gw = vcu * NWAVES + wave, NGW = G * NWAVES;
    Ptrs P; unsigned char* ws = args.ws;
    P.x = args.in[0]; P.p = args.in[1]; P.relb = args.in[2]; P.g_mix = args.in[3]; P.w_in = args.in[4]; P.pool_w = args.in[5]; P.pool_scale = args.in[6]; P.w_oa = args.in[7];
    P.w_op = args.in[8]; P.w_out = args.in[9]; P.g_ffn = args.in[10]; P.rw = args.in[11]; P.rb = args.in[12]; P.w_gu = args.in[13]; P.b_gu = args.in[14]; P.w_d = args.in[15];
    P.b_d = args.in[16]; P.g_ple = args.in[17]; P.w_pg = args.in[18]; P.w_pp = args.in[19]; P.g_fin = args.in[20];
    P.out = args.out; P.ws = ws; P.ctl = (gu32*)(ws + WS_CTL);
    P.WinT = (bf16*)(ws + WS_WIN); P.WaT = (bf16*)(ws + WS_WA); P.WcT = (bf16*)(ws + WS_WC); P.WoutT = (bf16*)(ws + WS_WOUT); P.WpgT = (bf16*)(ws + WS_WPG); P.WppT = (bf16*)(ws + WS_WPP);
    P.WguT = (bf16*)(ws + WS_WGU); P.WdT = (bf16*)(ws + WS_WD); P.XB = (bf16*)(ws + WS_XB); P.PB = (bf16*)(ws + WS_PB); P.QKVU = (bf16*)(ws + WS_QKVU); P.GATES = (bf16*)(ws + WS_GATES);
    P.PIN = (bf16*)(ws + WS_PIN); P.ATT = (bf16*)(ws + WS_ATT); P.TMP = (bf16*)(ws + WS_TMP); P.MERGED = (bf16*)(ws + WS_MERGED); P.X1N = (bf16*)(ws + WS_X1N); P.XG = (bf16*)(ws + WS_XG);
    P.VT = (bf16*)(ws + WS_XG); P.ATT2 = (bf16*)(ws + WS_TMP); P.H = (bf16*)(ws + WS_H); P.Y = (bf16*)(ws + WS_Y); P.X2N = (bf16*)(ws + WS_X2N); P.PRJ = (bf16*)(ws + WS_PRJ);
    P.RSTD0 = (float*)(ws + WS_RSTD0); P.KMEAN = (float*)(ws + WS_KMEAN); P.TOPW = (float*)(ws + WS_TOPW); P.ROWW = (float*)(ws + WS_ROWW); P.TOPI = (int*)(ws + WS_TOPI); P.INV = (int*)(ws + WS_INV);

    { LANE_TID; for (int u = tid; u < (LDS_BYTES - RING_BYTES) / 4; u += NWAVES * 64) ((LAS unsigned*)(lds + RING_BYTES))[u] = 0u; }
    __syncthreads();
    XcdBarrier bar; bar.bar = (unsigned*)(P.ctl + CW_BAR); bar.x = 0; bar.st = nullptr;
    if (MK_N_LAUNCHES == 1) bar = xcd_barrier_post((unsigned*)(P.ctl + CW_BAR), MISC + 8);
    const int lo = args.ph_lo, hi = args.ph_hi;
#define IN(k) (lo <= (k) && (k) < hi)
#define SEAM(k) do { if (IN(k) && IN((k) + 1)) xcd_barrier(bar); } while (0)

    if (IN(0)) { LANE_TID; p0_prologue(P, lds, gw, NGW, wave, lane); } SEAM(0);
    if (IN(1)) { pg8::Gemm g{P.XB, P.WinT, M, INC, D, wave}; pg8::StaticOrder S; S.init(M, INC, G, bx);
        mk::EpiInProj E{P.QKVU, P.GATES, P.RSTD0}; pg8::gemm_phase<mk::EpiInProj, pg8::StaticOrder, true, true>(lds, g, S, E); } SEAM(1);
    if (IN(2)) { LANE_TID; p2_kmean_pin(P, lds, G, tid, gw, NGW, lane); } SEAM(2);
    if (IN(3)) { LANE_TID;
#if MK_ATTN_SIMPLE
        p3_attn_simple(P, P.ATT, gw, NGW, lane);
#else
        moba::attn_phase(P, lds, vcu, G, tid, wave, lane);
#endif
    } SEAM(3);
    if (IN(4)) {
        { pg8::Gemm g{P.ATT, P.WaT, M, D, AW, wave}; pg8::StaticOrder S; S.init(M, D, G, bx);
          mk::EpiGateMul<false> E{P.GATES, 0, nullptr, P.TMP}; pg8::gemm_phase<mk::EpiGateMul<false>, pg8::StaticOrder, true, true>(lds, g, S, E); }
        VM_WAIT(); __syncthreads();
        { pg8::Gemm g{P.PIN, P.WcT, M, D, PW, wave}; pg8::StaticOrder S; S.init(M, D, G, bx);
          mk::EpiGateMul<true> E{P.GATES, D, P.TMP, P.MERGED}; pg8::gemm_phase<mk::EpiGateMul<true>, pg8::StaticOrder, true, true>(lds, g, S, E); }
    } SEAM(4);
    if (IN(5)) { pg8::Gemm g{P.MERGED, P.WoutT, M, D, D, wave}; pg8::StaticOrder S; S.init(M, D, G, bx);
        mk::EpiResF32 E{P.x, P.out}; pg8::gemm_phase<mk::EpiResF32, pg8::StaticOrder, true, true>(lds, g, S, E); } SEAM(5);
    if (IN(6)) { LANE_TID; p6_router(P, lds, G, tid, wave, lane); } SEAM(6);
    if (IN(7)) { LANE_TID; p7_permute(P, lds, G, tid, wave, lane); } SEAM(7);
    if (IN(8)) { pg8::Gemm g{P.XG, P.WguT, MAXROWS, NE * 2048, D, wave}; mk::MoeOrder S; S.init(P.ctl + CW_TILES, 8, G, bx);
        mk::EpiGlu E{P.b_gu, P.H}; pg8::gemm_phase<mk::EpiGlu, mk::MoeOrder, true, true>(lds, g, S, E); } SEAM(8);
    if (IN(9)) { pg8::Gemm g{P.H, P.WdT, MAXROWS, NE * D, FF, wave}; mk::MoeOrder S; S.init(P.ctl + CW_TILES, 4, G, bx);
        mk::EpiDown E{P.b_d, P.ROWW, P.Y}; pg8::gemm_phase<mk::EpiDown, mk::MoeOrder, true, true>(lds, g, S, E); } SEAM(9);
    if (IN(10)) { LANE_TID; p10_combine(P, gw, NGW, lane); } SEAM(10);
    if (IN(11)) {
        { pg8::Gemm g{P.PB, P.WppT, M, D, PLE, wave}; pg8::StaticOrder S; S.init(M, D, G, bx);
          mk::EpiBf E{P.PRJ}; pg8::gemm_phase<mk::EpiBf, pg8::StaticOrder, true, true>(lds, g, S, E); }
        VM_WAIT(); __syncthreads();
        { pg8::Gemm g{P.X2N, P.WpgT, M, D, D, wave}; pg8::StaticOrder S; S.init(M, D, G, bx);
          mk::EpiPle E{P.out, P.PRJ}; pg8::gemm_phase<mk::EpiPle, pg8::StaticOrder, true, true>(lds, g, S, E); }
    } SEAM(11);
    if (IN(12)) { LANE_TID; p12_final(P, gw, NGW, lane); }
#undef IN
#undef SEAM
}

extern "C" void kernel_launch(void* const* d_in, const int* in_sizes, int n_in, void* d_out, int out_size, void* d_ws, size_t ws_size, hipStream_t stream) {
    static int grid = 0;
    if (grid == 0) {
        if (n_in != 21 || in_sizes[0] != M * D || out_size != M * D || ws_size < WS_END) { fprintf(stderr, "kernel_launch: unexpected shapes (n_in %d, in0 %d, out %d, ws %zu)\n", n_in, n_in > 0 ? in_sizes[0] : -1, out_size, ws_size); grid = -1; return; }
        int dev = 0, cus = 0;
        if (hipGetDevice(&dev) != hipSuccess || hipDeviceGetAttribute(&cus, hipDeviceAttributeMultiprocessorCount, dev) != hipSuccess) { grid = -1; return; }
        grid = cus;
    }
    if (grid < 0) return;
    (void)hipMemsetAsync((char*)d_ws + WS_CTL, 0, CTL_ZERO_BYTES, stream);
    Args a{};
    for (int i = 0; i < 21; ++i) a.in[i] = (const float*)d_in[i];
    a.out = (float*)d_out; a.ws = (unsigned char*)d_ws;
    if (MK_N_LAUNCHES == 1) { a.ph_lo = 0; a.ph_hi = NPH; hipLaunchKernelGGL(mk_fwd, dim3(grid), dim3(NWAVES * 64), 0, stream, a); }
    else for (int k = 0; k < NPH; ++k) { a.ph_lo = k; a.ph_hi = k + 1; hipLaunchKernelGGL(mk_fwd, dim3(grid), dim3(NWAVES * 64), 0, stream, a); }
}
```

```cpp
#include <hip/hip_runtime.h>
#include <cstdio>
#include <cstdint>
__device__ __forceinline__ int mk_lane_now() { int l; asm volatile("v_mbcnt_lo_u32_b32 %0, -1, 0\n\tv_mbcnt_hi_u32_b32 %0, -1, %0" : "=v"(l)); return l; }
namespace pg8 {
#define PG8_LAS __attribute__((address_space(3)))
typedef unsigned short bf16_t;
typedef short bf16x8 __attribute__((ext_vector_type(8)));
typedef float f32x4 __attribute__((ext_vector_type(4)));
typedef unsigned u32x4 __attribute__((ext_vector_type(4)));
constexpr int BM = 256, BK = 64, HALF = 128, HTB = HALF * BK * 2  , STAGE_BYTES = 8 * HTB, NXCD = 8, WGM = 8;

__host__ __device__ __forceinline__ int lds_byte(int r, int c) { const int st = (r >> 4) * 2 + (c >> 5), rr = r & 15, cc = c & 31, ob = rr * 64 + cc * 2; return st * 1024 + (ob ^ (((ob >> 9) & 1) << 5)); }
__host__ __device__ __forceinline__ void stage_rc(int b, int& R, int& C) { const int st = b / 1024, sb = b % 1024, swz = sb ^ (((sb >> 9) & 1) << 5); R = (st >> 1) * 16 + swz / 64; C = (st & 1) * 32 + (swz % 64) / 2; }
__host__ __device__ __forceinline__ int perm32(int rho) { const int n = rho >> 4, i = rho & 15; return 8 * (i >> 2) + 4 * n + (i & 3); }

struct Unit { int pm, pn; };
struct Gemm { const bf16_t* A; const bf16_t* Bt; int M, N, K, wid; };

struct StaticOrder {
    int nM, nN, nwg, G, c;
    __host__ __device__ void init(int M, int N, int G_, int c_) { nM = M / BM; nN = N / BM; nwg = nM * nN; G = G_; c = c_; }
    __host__ __device__ bool next(int i, Unit& u) const {
        const long L = (long)i * G + c; if (L >= nwg) return false;
        int wgid = (int)L; { const int q = nwg / NXCD, r = nwg % NXCD, xcd = wgid % NXCD, off = wgid / NXCD; wgid = (xcd < r ? xcd * (q + 1) : r * (q + 1) + (xcd - r) * q) + off; }
        const int nig = WGM * nN, gid = wgid / nig, fm = gid * WGM, gsz = (nM - fm) < WGM ? (nM - fm) : WGM;
        u.pm = fm + ((wgid % nig) % gsz); u.pn = (wgid % nig) / gsz; return true;
    }
    __device__ __forceinline__ void a_ready(const Unit&) const {}
    __device__ __forceinline__ void done(const Unit&) const {}
};
__device__ __forceinline__ unsigned cvt_pk_bf16(float lo, float hi) { unsigned r; asm volatile("v_cvt_pk_bf16_f32 %0, %1, %2" : "=v"(r) : "v"(lo), "v"(hi)); return r; }
template <class Epi, class Sched, bool ALIGN_EPI = false, bool SP2 = false>
__device__ __forceinline__ void gemm_phase(PG8_LAS unsigned char* lds, const Gemm g, const Sched& S, const Epi& E) {
    const int wid = g.wid, lane = mk_lane_now(), tid = wid * 64 + lane, wr = wid >> 2, wc = wid & 3, fr = lane & 15, fq = lane >> 4;
    int K_ = g.K; asm volatile("" : "+s"(K_)); const int K = K_, nt = K / BK;
    unsigned voffA[2], voffB[2];
#pragma unroll
    for (int i = 0; i < 2; ++i) { int R, C; stage_rc(tid * 16 + i * 8192, R, C); const int Rb = Epi::PERM ? ((R & ~31) + perm32(R & 31)) : R;
        voffA[i] = (unsigned)(R * K + C) * 2u; voffB[i] = (unsigned)(Rb * K + C) * 2u; }
    const size_t kstep = (size_t)(BK * 2);
    const size_t hstep = (size_t)HALF * K * 2;
    const size_t tstep = 2 * hstep;
    const unsigned ldsw = (unsigned)wid * 1024u;
    const int aoff = lds_byte(wr * 64 + fr, fq * 8), boff = lds_byte(wc * 32 + fr, fq * 8);
#define PG8_SA(b, h) (((b) * 2 + (h)) * HTB)
#define PG8_SB(b, h) ((4 + (b) * 2 + (h)) * HTB)
#define PG8_STAGE(bufoff, gbase, voff) do { _Pragma("unroll") for (int _i = 0; _i < 2; ++_i) \
        __builtin_amdgcn_global_load_lds((const unsigned*)((const char*)(gbase) + (voff)[_i]), (PG8_LAS unsigned*)(lds + (bufoff) + ldsw + _i * 8192), 16, 0, 0); } while (0)
#define PG8_LDA(dst, b, h) do { _Pragma("unroll") for (int m = 0; m < 4; ++m) _Pragma("unroll") for (int k = 0; k < 2; ++k) dst[m][k] = *(const PG8_LAS bf16x8*)(lds + PG8_SA(b, h) + aoff + m * 2048 + k * 1024); } while (0)
#define PG8_LDB(dst, b, h) do { _Pragma("unroll") for (int n = 0; n < 2; ++n) _Pragma("unroll") for (int k = 0; k < 2; ++k) dst[n][k] = *(const PG8_LAS bf16x8*)(lds + PG8_SB(b, h) + boff + n * 2048 + k * 1024); } while (0)
#define PG8_MMA(ai, bj, At, Bt) do { __builtin_amdgcn_s_setprio(1); _Pragma("unroll") for (int m = 0; m < 4; ++m) _Pragma("unroll") for (int n = 0; n < 2; ++n) _Pragma("unroll") for (int k = 0; k < 2; ++k) \
        acc[ai][bj][m][n] = __builtin_amdgcn_mfma_f32_16x16x32_bf16(Bt[n][k], At[m][k], acc[ai][bj][m][n], 0, 0, 0); __builtin_amdgcn_s_setprio(0); } while (0)
#define PG8_WAIT_V(n) asm volatile("s_waitcnt vmcnt(" #n ")" ::: "memory")
#define PG8_WAIT_L(n) asm volatile("s_waitcnt lgkmcnt(" #n ")" ::: "memory")
#define PG8_BAR __builtin_amdgcn_s_barrier()
#define PG8_SCHED __builtin_amdgcn_sched_barrier(0)
    Unit cur, nxt; int ui = 0;
    if (!S.next(0, cur)) return;
    f32x4 acc[2][2][4][2];
#pragma unroll
    for (int a = 0; a < 2; ++a)
#pragma unroll
        for (int b = 0; b < 2; ++b)
#pragma unroll
            for (int m = 0; m < 4; ++m)
#pragma unroll
                for (int n = 0; n < 2; ++n) acc[a][b][m][n] = (f32x4){0.f, 0.f, 0.f, 0.f};
    bf16x8 At[4][2], B0[2][2], B1[2][2];
    const char* cA = (const char*)g.A + (size_t)cur.pm * tstep; const char* cB = (const char*)g.Bt + (size_t)cur.pn * tstep;
    S.a_ready(cur);
    if constexpr (SP2) {
        PG8_STAGE(PG8_SB(0, 0), cB, voffB); PG8_STAGE(PG8_SB(0, 1), cB + hstep, voffB); PG8_STAGE(PG8_SA(0, 0), cA, voffA); PG8_STAGE(PG8_SA(0, 1), cA + hstep, voffA);
        if (wr == 1) PG8_BAR;
        PG8_WAIT_V(2); PG8_BAR;
        PG8_STAGE(PG8_SB(1, 0), cB + kstep, voffB); PG8_STAGE(PG8_SA(1, 0), cA + kstep, voffA); PG8_STAGE(PG8_SB(1, 1), cB + hstep + kstep, voffB);
        PG8_WAIT_V(6); PG8_BAR;
    } else {
        PG8_STAGE(PG8_SB(0, 0), cB, voffB); PG8_STAGE(PG8_SA(0, 0), cA, voffA); PG8_STAGE(PG8_SB(0, 1), cB + hstep, voffB); PG8_STAGE(PG8_SA(0, 1), cA + hstep, voffA);
        if (wr == 1) PG8_BAR;
        PG8_WAIT_V(4); PG8_BAR;
        PG8_STAGE(PG8_SB(1, 0), cB + kstep, voffB); PG8_STAGE(PG8_SA(1, 0), cA + kstep, voffA); PG8_STAGE(PG8_SB(1, 1), cB + hstep + kstep, voffB);
        PG8_WAIT_V(6); PG8_BAR;
    }
    for (;;) {
        const bool has_next = S.next(ui + 1, nxt);
        const char* nA = has_next ? (const char*)g.A + (size_t)nxt.pm * tstep : cA; const char* nB = has_next ? (const char*)g.Bt + (size_t)nxt.pn * tstep : cB;
        for (int t = 0; t < nt; t += 2) {
            const bool last = (t == nt - 2);
            const char* a1 = cA + (size_t)(t + 1) * kstep;
            const char* a2 = last ? nA : cA + (size_t)(t + 2) * kstep; const char* b2 = last ? nB : cB + (size_t)(t + 2) * kstep;
            const char* a3 = a2 + kstep; const char* b3 = b2 + kstep;
            if (last && has_next) S.a_ready(nxt);
            if constexpr (SP2) {
            PG8_LDB(B0, 0, 0); PG8_LDB(B1, 0, 1); PG8_SCHED; PG8_LDA(At, 0, 0); PG8_STAGE(PG8_SA(1, 1), a1 + hstep, voffA);
            PG8_WAIT_V(8); PG8_WAIT_L(0); PG8_BAR; PG8_MMA(0, 0, At, B0); PG8_MMA(0, 1, At, B1); PG8_BAR; PG8_SCHED;
            PG8_LDA(At, 0, 1); PG8_STAGE(PG8_SB(0, 0), b2, voffB); PG8_STAGE(PG8_SB(0, 1), b2 + hstep, voffB); PG8_STAGE(PG8_SA(0, 0), a2, voffA);
            PG8_WAIT_V(8); PG8_WAIT_L(0); PG8_BAR; PG8_MMA(1, 0, At, B0); PG8_MMA(1, 1, At, B1); PG8_BAR; PG8_SCHED;
            PG8_LDB(B0, 1, 0); PG8_LDB(B1, 1, 1); PG8_SCHED; PG8_LDA(At, 1, 0); PG8_STAGE(PG8_SA(0, 1), a2 + hstep, voffA);
            PG8_WAIT_V(8); PG8_WAIT_L(0); PG8_BAR; PG8_MMA(0, 0, At, B0); PG8_MMA(0, 1, At, B1); PG8_BAR; PG8_SCHED;
            PG8_LDA(At, 1, 1); PG8_STAGE(PG8_SB(1, 0), b3, voffB); PG8_STAGE(PG8_SB(1, 1), b3 + hstep, voffB); PG8_STAGE(PG8_SA(1, 0), a3, voffA);
            PG8_WAIT_V(8); PG8_WAIT_L(0); PG8_BAR; PG8_MMA(1, 0, At, B0); PG8_MMA(1, 1, At, B1); PG8_BAR; PG8_SCHED;
            } else {
            PG8_LDB(B0, 0, 0); PG8_SCHED; PG8_LDA(At, 0, 0); PG8_STAGE(PG8_SA(1, 1), a1 + hstep, voffA);
            PG8_WAIT_L(8); PG8_BAR; PG8_WAIT_L(0); PG8_MMA(0, 0, At, B0); PG8_BAR; PG8_SCHED;
            PG8_LDB(B1, 0, 1); PG8_STAGE(PG8_SB(0, 0), b2, voffB);
            PG8_BAR; PG8_WAIT_L(0); PG8_MMA(0, 1, At, B1); PG8_BAR;
            PG8_LDA(At, 0, 1); PG8_STAGE(PG8_SA(0, 0), a2, voffA);
            PG8_BAR; PG8_WAIT_L(0); PG8_MMA(1, 0, At, B0); PG8_BAR; PG8_SCHED;
            PG8_STAGE(PG8_SB(0, 1), b2 + hstep, voffB);
            PG8_WAIT_V(6); PG8_BAR; PG8_MMA(1, 1, At, B1); PG8_BAR;
            PG8_LDB(B0, 1, 0); PG8_SCHED; PG8_LDA(At, 1, 0); PG8_STAGE(PG8_SA(0, 1), a2 + hstep, voffA);
            PG8_WAIT_L(8); PG8_BAR; PG8_WAIT_L(0); PG8_MMA(0, 0, At, B0); PG8_BAR; PG8_SCHED;
            PG8_LDB(B1, 1, 1); PG8_STAGE(PG8_SB(1, 0), b3, voffB);
            PG8_BAR; PG8_WAIT_L(0); PG8_MMA(0, 1, At, B1); PG8_BAR;
            PG8_LDA(At, 1, 1); PG8_STAGE(PG8_SA(1, 0), a3, voffA);
            PG8_BAR; PG8_WAIT_L(0); PG8_MMA(1, 0, At, B0); PG8_BAR; PG8_SCHED;
            PG8_STAGE(PG8_SB(1, 1), b3 + hstep, voffB);
            PG8_WAIT_V(6); PG8_BAR; PG8_MMA(1, 1, At, B1); PG8_BAR;
            }
        }
        if constexpr (ALIGN_EPI) { if (wr == 0) PG8_BAR; }
        if constexpr (!Epi::AFTER_DRAIN) { E(acc, cur, wr, wc, fr, fq); S.done(cur); }
        if (!has_next) break;
#pragma unroll
        for (int a = 0; a < 2; ++a)
#pragma unroll
            for (int b = 0; b < 2; ++b)
#pragma unroll
                for (int m = 0; m < 4; ++m)
#pragma unroll
                    for (int n = 0; n < 2; ++n) acc[a][b][m][n] = (f32x4){0.f, 0.f, 0.f, 0.f};
        cur = nxt; cA = nA; cB = nB; ++ui;
        if constexpr (ALIGN_EPI) { if (wr == 1) PG8_BAR; }
    }
    PG8_WAIT_V(0);
    if constexpr (!ALIGN_EPI) { if (wr == 0) PG8_BAR; }
    PG8_BAR;
    if constexpr (Epi::AFTER_DRAIN) { E.fused(acc, cur, wr, wc, fr, fq, lds, wid, lane); S.done(cur); }
#undef PG8_SA
#undef PG8_SB
#undef PG8_STAGE
#undef PG8_LDA
#undef PG8_LDB
#undef PG8_MMA
#undef PG8_WAIT_V
#undef PG8_WAIT_L
#undef PG8_BAR
#undef PG8_SCHED
}
}
#define GAS __attribute__((address_space(1)))
#define LAS __attribute__((address_space(3)))
#define XB_TMO      128
#define XB_XCNT(j)  (256  + 64 * (j))
#define XB_XSUB(j)  (1280 + 64 * (j))
#define XB_XGEN(j)  (2304 + 64 * (j))
#define XB_TOP      3328
#define XB_TOPGEN   3392
#define XCD_BAR_WORDS 3456
#define XB_SPIN_CAP (1u << 18)

__device__ __forceinline__ unsigned xb_ld(unsigned* p)              { return __hip_atomic_load(p, __ATOMIC_RELAXED, __HIP_MEMORY_SCOPE_AGENT); }
__device__ __forceinline__ unsigned xb_add(unsigned* p, unsigned v) { return __hip_atomic_fetch_add(p, v, __ATOMIC_RELAXED, __HIP_MEMORY_SCOPE_AGENT); }
__device__ __forceinline__ unsigned xb_xcc_id() { return (unsigned)__builtin_amdgcn_s_getreg((3 << 11) | 20) & 0xFu; }
#define XB_SPIN(cond, bar) do { unsigned _sp = 0; while (cond) { __builtin_amdgcn_s_sleep(1); \
    if ((++_sp & 255u) == 0u) { if (xb_ld(&(bar)[XB_TMO])) break; if (_sp > XB_SPIN_CAP) { atomicAdd(&(bar)[XB_TMO], 1u); break; } } } } while (0)

struct XcdBarrier {
    unsigned* bar; unsigned x;
    volatile LAS unsigned* st;
};

__device__ __forceinline__ XcdBarrier xcd_barrier_post(unsigned* bar, volatile LAS unsigned* st) {
    XcdBarrier b; b.bar = bar; b.x = xb_xcc_id(); b.st = st;
    if (threadIdx.x == 0) (void)xb_add(&bar[XB_XCNT(b.x)], 1u);
    return b;
}
__device__ __forceinline__ void xcd_barrier_complete(unsigned* bar, unsigned x, unsigned& nloc, unsigned& nx) {
    const unsigned G = gridDim.x * gridDim.y * gridDim.z;
    unsigned sum, cnt, mine, sp = 0u;
    for (;;) {
        sum = 0u; cnt = 0u; mine = 0u;
#pragma unroll
        for (unsigned j = 0; j < 16; ++j) { const unsigned c = xb_ld(&bar[XB_XCNT(j)]); sum += c; cnt += (c > 0u) ? 1u : 0u; mine = (j == x) ? c : mine; }
        if (sum == G) break;
        __builtin_amdgcn_s_sleep(1);
        if ((++sp & 255u) == 0u) { if (xb_ld(&bar[XB_TMO])) break; if (sp > XB_SPIN_CAP) { atomicAdd(&bar[XB_TMO], 1u); break; } }
    }
    nloc = mine > 0u ? mine : 1u; nx = cnt > 0u ? cnt : 1u;
}

__device__ __forceinline__ void xcd_barrier(const XcdBarrier& b) {
    asm volatile("s_waitcnt vmcnt(0)" ::: "memory");
    __syncthreads();
    if (threadIdx.x == 0) {
        unsigned* bar = b.bar;
        __builtin_amdgcn_s_waitcnt(0);
        unsigned nloc = b.st[0], nx = b.st[1];
        if (nloc == 0u) { xcd_barrier_complete(bar, b.x, nloc, nx); b.st[0] = nloc; b.st[1] = nx; }
        const unsigned old = xb_add(&bar[XB_XSUB(b.x)], 1u);
        const unsigned gen = old / nloc;
        if (old + 1u == (gen + 1u) * nloc) {
            __builtin_amdgcn_fence(__ATOMIC_RELEASE, "agent");
            asm volatile("s_waitcnt vmcnt(0)" ::: "memory");
            const unsigned og = xb_add(&bar[XB_TOP], 1u);
            const unsigned tg = og / nx;
            if (og + 1u == (tg + 1u) * nx) xb_add(&bar[XB_TOPGEN], 1u);
            else XB_SPIN(xb_ld(&bar[XB_TOPGEN]) == tg, bar);
            __builtin_amdgcn_fence(__ATOMIC_ACQUIRE, "agent");
            xb_add(&bar[XB_XGEN(b.x)], 1u);
            asm volatile("s_waitcnt vmcnt(0)" ::: "memory");
        } else {
            XB_SPIN(xb_ld(&bar[XB_XGEN(b.x)]) == gen, bar);
            __builtin_amdgcn_fence(__ATOMIC_ACQUIRE, "agent");
            asm volatile("s_waitcnt vmcnt(0)" ::: "memory");
        }
    }
    __syncthreads();
}

#ifndef MK_ATTN_SIMPLE
#define MK_ATTN_SIMPLE 0
#endif
#ifndef MK_DUP_MASK
#define MK_DUP_MASK 0
#endif
#ifndef MK_N_LAUNCHES
#define MK_N_LAUNCHES 1
#endif
constexpr int NWAVES = 8;
constexpr int BATCH = 2, SEQ = 8192, D = 1024, M = BATCH * SEQ;
constexpr int NH = 8, HD = 64, AW = 512, PW = 512, INC = 4096;
constexpr int NE = 32, FF = 1024, PLE = 256, MOBA = 256, NBLK = SEQ / MOBA;
constexpr int QP = 2048;
constexpr int MAXROWS = M * 4 + NE * 256;
constexpr float RMS_EPS = 1e-6f;
constexpr float LOG2E = 1.4426950408889634f;
constexpr int NPH = 13;

constexpr size_t MiB = 1u << 20;
constexpr size_t WS_CTL = 0, CTL_ZERO_BYTES = 1 * MiB;
constexpr size_t WS_WIN = 2 * MiB, WS_WA = 10 * MiB, WS_WC = 11 * MiB, WS_WOUT = 12 * MiB, WS_WPG = 14 * MiB, WS_WPP = 16 * MiB;
constexpr size_t WS_RSTD0 = 17 * MiB, WS_KMEAN = WS_RSTD0 + 256 * 1024, WS_TOPI = WS_KMEAN + 256 * 1024, WS_TOPW = WS_TOPI + 256 * 1024;
constexpr size_t WS_INV = 18 * MiB, WS_ROWW = WS_INV + 256 * 1024;
constexpr size_t WS_WGU = 32 * MiB, WS_WD = 160 * MiB, WS_XB = 224 * MiB, WS_PB = 256 * MiB, WS_QKVU = 264 * MiB, WS_GATES = 328 * MiB;
constexpr size_t WS_PIN = 392 * MiB, WS_ATT = 408 * MiB, WS_TMP = 424 * MiB, WS_MERGED = 456 * MiB, WS_X1N = 488 * MiB;
constexpr size_t WS_XG = 520 * MiB, WS_H = 664 * MiB, WS_Y = 808 * MiB, WS_X2N = 952 * MiB, WS_PRJ = 984 * MiB, WS_END = 1016 * MiB;
static_assert(WS_ROWW + (size_t)MAXROWS * 4 <= 19 * MiB && WS_XG + (size_t)MAXROWS * 1024 * 2 <= WS_H && WS_Y + (size_t)MAXROWS * 1024 * 2 <= WS_X2N, "d_ws map");
constexpr int CW_TMO = 0, CW_CODE = 1, CW_BAR = 4096, CW_CNT = 16384, CW_TILES = 32768;
constexpr int LDS_BYTES = 147456, RING_BYTES = 131072, MISC_OFF = RING_BYTES + 320;

typedef unsigned short bf16;
typedef unsigned v4u __attribute__((ext_vector_type(4)));
typedef unsigned v2u __attribute__((ext_vector_type(2)));
typedef float f32x4 __attribute__((ext_vector_type(4)));
typedef GAS unsigned gu32;
#define RLX_AGENT __ATOMIC_RELAXED, __HIP_MEMORY_SCOPE_AGENT
#define LDS_WAIT() asm volatile("s_waitcnt lgkmcnt(0)" ::: "memory")
#define VM_WAIT() asm volatile("s_waitcnt vmcnt(0)" ::: "memory")
__device__ __forceinline__ unsigned f2bf(float f) { unsigned u = __builtin_bit_cast(unsigned, f); return (u + 0x7fffu + ((u >> 16) & 1u)) >> 16; }
typedef float mk_f32x2 __attribute__((ext_vector_type(2))); typedef __bf16 mk_bf16x2 __attribute__((ext_vector_type(2)));
__device__ __forceinline__ unsigned pk2(float lo, float hi) { mk_f32x2 v = {lo, hi}; return __builtin_bit_cast(unsigned, __builtin_convertvector(v, mk_bf16x2)); }
__device__ __forceinline__ float bflo(unsigned w) { return __uint_as_float(w << 16); }
__device__ __forceinline__ float bfhi(unsigned w) { return __uint_as_float(w & 0xffff0000u); }
__device__ __forceinline__ float bf2f(bf16 h) { return __uint_as_float((unsigned)h << 16); }
__device__ __forceinline__ float sigm(float x) { return __builtin_amdgcn_rcpf(1.0f + __builtin_amdgcn_exp2f(-LOG2E * x)); }
__device__ __forceinline__ float wave_sum(float v) {
#pragma unroll
    for (int o = 1; o < 64; o <<= 1) v += __shfl_xor(v, o);
    return v;
}
__device__ __forceinline__ float wave_max(float v) {
#pragma unroll
    for (int o = 1; o < 64; o <<= 1) v = fmaxf(v, __shfl_xor(v, o));
    return v;
}
__device__ __forceinline__ unsigned ld_ctl(const gu32* p) { return (unsigned)__builtin_amdgcn_readfirstlane((int)__hip_atomic_load(p, RLX_AGENT)); }

namespace mk {
using pg8::Unit; using pg8::BM; using pg8::HALF; using pg8::u32x4; using pg8::cvt_pk_bf16;
struct EpiInProj {
    static constexpr bool PERM = true, AFTER_DRAIN = false;
    bf16* qkvu; bf16* gates; const float* rstd;
    __device__ __forceinline__ void operator()(const f32x4 (&acc)[2][2][4][2], const Unit& u, int wr, int wc, int fr, int fq) const {
        const int row0 = u.pm * BM + wr * 64 + fr; const bool isg = u.pn >= 8;
        bf16* base = isg ? gates : qkvu; const int col0 = (u.pn & 7) * BM + wc * 32 + 8 * fq; const float qs = (u.pn < 2) ? 0.125f * LOG2E : 1.0f;
#pragma unroll
        for (int ai = 0; ai < 2; ++ai)
#pragma unroll
            for (int m = 0; m < 4; ++m) { const int row = row0 + ai * HALF + m * 16; const float rs = rstd[row] * qs; bf16* rowp = base + (size_t)row * QP + col0;
#pragma unroll
                for (int bj = 0; bj < 2; ++bj) { f32x4 v0 = acc[ai][bj][m][0] * rs, v1 = acc[ai][bj][m][1] * rs;
                    if (isg) { v0 = (f32x4){sigm(v0[0]), sigm(v0[1]), sigm(v0[2]), sigm(v0[3])}; v1 = (f32x4){sigm(v1[0]), sigm(v1[1]), sigm(v1[2]), sigm(v1[3])}; }
                    u32x4 w; w.x = cvt_pk_bf16(v0[0], v0[1]); w.y = cvt_pk_bf16(v0[2], v0[3]); w.z = cvt_pk_bf16(v1[0], v1[1]); w.w = cvt_pk_bf16(v1[2], v1[3]);
                    *(u32x4*)(rowp + bj * HALF) = w; } }
    }
};
template <bool ADD> struct EpiGateMul {
    static constexpr bool PERM = true, AFTER_DRAIN = false;
    const bf16* gates; int goff; const bf16* add; bf16* out;
    __device__ __forceinline__ void operator()(const f32x4 (&acc)[2][2][4][2], const Unit& u, int wr, int wc, int fr, int fq) const {
        const int row0 = u.pm * BM + wr * 64 + fr; const int col0 = u.pn * BM + wc * 32 + 8 * fq;
#pragma unroll
        for (int ai = 0; ai < 2; ++ai)
#pragma unroll
            for (int m = 0; m < 4; ++m) { const int row = row0 + ai * HALF + m * 16;
#pragma unroll
                for (int bj = 0; bj < 2; ++bj) { const int c = col0 + bj * HALF;
                    const u32x4 g = *(const u32x4*)(gates + (size_t)row * QP + goff + c);
                    f32x4 v0 = acc[ai][bj][m][0] * (f32x4){bflo(g.x), bfhi(g.x), bflo(g.y), bfhi(g.y)}, v1 = acc[ai][bj][m][1] * (f32x4){bflo(g.z), bfhi(g.z), bflo(g.w), bfhi(g.w)};
                    if (ADD) { const u32x4 a = *(const u32x4*)(add + (size_t)row * D + c); v0 += (f32x4){bflo(a.x), bfhi(a.x), bflo(a.y), bfhi(a.y)}; v1 += (f32x4){bflo(a.z), bfhi(a.z), bflo(a.w), bfhi(a.w)}; }
                    u32x4 w; w.x = cvt_pk_bf16(v0[0], v0[1]); w.y = cvt_pk_bf16(v0[2], v0[3]); w.z = cvt_pk_bf16(v1[0], v1[1]); w.w = cvt_pk_bf16(v1[2], v1[3]);
                    *(u32x4*)(out + (size_t)row * D + c) = w; } }
    }
};
struct EpiResF32 {
    static constexpr bool PERM = false, AFTER_DRAIN = false;
    const float* base; float* out;
    __device__ __forceinline__ void operator()(const f32x4 (&acc)[2][2][4][2], const Unit& u, int wr, int wc, int fr, int fq) const {
        const int row0 = u.pm * BM + wr * 64 + fr; const int col0 = u.pn * BM + wc * 32 + 4 * fq;
#pragma unroll
        for (int ai = 0; ai < 2; ++ai)
#pragma unroll
            for (int m = 0; m < 4; ++m) { const size_t off = (size_t)(row0 + ai * HALF + m * 16) * D + col0;
#pragma unroll
                for (int bj = 0; bj < 2; ++bj)
#pragma unroll
                    for (int n = 0; n < 2; ++n) { const f32x4 b = *(const f32x4*)(base + off + bj * HALF + n * 16); *(f32x4*)(out + off + bj * HALF + n * 16) = b + acc[ai][bj][m][n]; } }
    }
};
__device__ __forceinline__ float glu1(float g, float l) { g = fminf(g, 7.0f); l = fminf(fmaxf(l, -7.0f), 7.0f); return (l + 1.0f) * g * __builtin_amdgcn_rcpf(1.0f + __builtin_amdgcn_exp2f(-1.702f * LOG2E * g)); }
struct EpiGlu {
    static constexpr bool PERM = true, AFTER_DRAIN = false;
    const float* bgu; bf16* H;
    __device__ __forceinline__ void operator()(const f32x4 (&acc)[2][2][4][2], const Unit& u, int wr, int wc, int fr, int fq) const {
        const int e = u.pn >> 3, pnl = u.pn & 7; const int row0 = u.pm * BM + wr * 64 + fr; const int col0 = pnl * BM + wc * 32 + 8 * fq;
        f32x4 bv[2][2];
#pragma unroll
        for (int bj = 0; bj < 2; ++bj)
#pragma unroll
            for (int n = 0; n < 2; ++n) bv[bj][n] = *(const f32x4*)(bgu + (size_t)e * 2048 + col0 + bj * HALF + 4 * n);
#pragma unroll
        for (int ai = 0; ai < 2; ++ai)
#pragma unroll
            for (int m = 0; m < 4; ++m) { const int row = row0 + ai * HALF + m * 16;
#pragma unroll
                for (int bj = 0; bj < 2; ++bj) { const f32x4 v0 = acc[ai][bj][m][0] + bv[bj][0], v1 = acc[ai][bj][m][1] + bv[bj][1];
                    v2u w; w.x = cvt_pk_bf16(glu1(v0[0], v0[1]), glu1(v0[2], v0[3])); w.y = cvt_pk_bf16(glu1(v1[0], v1[1]), glu1(v1[2], v1[3]));
                    *(v2u*)(H + (size_t)row * FF + ((col0 + bj * HALF) >> 1)) = w; } }
    }
};
struct EpiDown {
    static constexpr bool PERM = true, AFTER_DRAIN = false;
    const float* bd; const float* roww; bf16* Y;
    __device__ __forceinline__ void operator()(const f32x4 (&acc)[2][2][4][2], const Unit& u, int wr, int wc, int fr, int fq) const {
        const int e = u.pn >> 2, pnl = u.pn & 3; const int row0 = u.pm * BM + wr * 64 + fr; const int col0 = pnl * BM + wc * 32 + 8 * fq;
        f32x4 bv[2][2];
#pragma unroll
        for (int bj = 0; bj < 2; ++bj)
#pragma unroll
            for (int n = 0; n < 2; ++n) bv[bj][n] = *(const f32x4*)(bd + (size_t)e * D + col0 + bj * HALF + 4 * n);
#pragma unroll
        for (int ai = 0; ai < 2; ++ai)
#pragma unroll
            for (int m = 0; m < 4; ++m) { const int row = row0 + ai * HALF + m * 16; const float rw = roww[row];
#pragma unroll
                for (int bj = 0; bj < 2; ++bj) { const f32x4 v0 = (acc[ai][bj][m][0] + bv[bj][0]) * rw, v1 = (acc[ai][bj][m][1] + bv[bj][1]) * rw;
                    u32x4 w; w.x = cvt_pk_bf16(v0[0], v0[1]); w.y = cvt_pk_bf16(v0[2], v0[3]); w.z = cvt_pk_bf16(v1[0], v1[1]); w.w = cvt_pk_bf16(v1[2], v1[3]);
                    *(u32x4*)(Y + (size_t)row * D + col0 + bj * HALF) = w; } }
    }
};
struct EpiBf {
    static constexpr bool PERM = true, AFTER_DRAIN = false;
    bf16* out;
    __device__ __forceinline__ void operator()(const f32x4 (&acc)[2][2][4][2], const Unit& u, int wr, int wc, int fr, int fq) const {
        const int row0 = u.pm * BM + wr * 64 + fr; const int col0 = u.pn * BM + wc * 32 + 8 * fq;
#pragma unroll
        for (int ai = 0; ai < 2; ++ai)
#pragma unroll
            for (int m = 0; m < 4; ++m) { bf16* rowp = out + (size_t)(row0 + ai * HALF + m * 16) * D + col0;
#pragma unroll
                for (int bj = 0; bj < 2; ++bj) { const f32x4 v0 = acc[ai][bj][m][0], v1 = acc[ai][bj][m][1];
                    u32x4 w; w.x = cvt_pk_bf16(v0[0], v0[1]); w.y = cvt_pk_bf16(v0[2], v0[3]); w.z = cvt_pk_bf16(v1[0], v1[1]); w.w = cvt_pk_bf16(v1[2], v1[3]);
                    *(u32x4*)(rowp + bj * HALF) = w; } }
    }
};
struct EpiPle {
    static constexpr bool PERM = false, AFTER_DRAIN = false;
    float* xio; const bf16* prj;
    __device__ __forceinline__ void operator()(const f32x4 (&acc)[2][2][4][2], const Unit& u, int wr, int wc, int fr, int fq) const {
        const int row0 = u.pm * BM + wr * 64 + fr; const int col0 = u.pn * BM + wc * 32 + 4 * fq;
#pragma unroll
        for (int ai = 0; ai < 2; ++ai)
#pragma unroll
            for (int m = 0; m < 4; ++m) { const size_t off = (size_t)(row0 + ai * HALF + m * 16) * D + col0;
#pragma unroll
                for (int bj = 0; bj < 2; ++bj)
#pragma unroll
                    for (int n = 0; n < 2; ++n) { const size_t c = off + bj * HALF + n * 16; const f32x4 xv = *(const f32x4*)(xio + c); const v2u p = *(const v2u*)(prj + c); const f32x4 a = acc[ai][bj][m][n];
                        *(f32x4*)(xio + c) = xv + (f32x4){sigm(a[0]) * bflo(p.x), sigm(a[1]) * bfhi(p.x), sigm(a[2]) * bflo(p.y), sigm(a[3]) * bfhi(p.y)}; } }
    }
};
struct MoeOrder {
    const gu32* tiles; int TM, NT, G, c;
    __device__ __forceinline__ void init(const gu32* t, int nt, int G_, int c_) { tiles = t; NT = nt; G = G_; c = c_; TM = (int)ld_ctl(t); }
    __device__ __forceinline__ bool next(int i, Unit& u) const {
        const long L = (long)i * G + c; if (L >= (long)TM * NT) return false;
        const int mt = (int)(L / NT), pn = (int)(L % NT);
        u.pm = (int)ld_ctl(tiles + 64 + 2 * mt); u.pn = (int)ld_ctl(tiles + 64 + 2 * mt + 1) * NT + pn; return true;
    }
    __device__ __forceinline__ void a_ready(const Unit&) const {}
    __device__ __forceinline__ void done(const Unit&) const {}
};
}

__device__ __forceinline__ void tr_item(const float* W, int K, int N, const float* ks, bf16* WT, int item, int lane) {
    const int nblk = N / 32, kb = item / nblk, nb = item % nblk, nc = lane >> 3, kr = lane & 7;
    const float* src = W + (size_t)(64 * kb + 8 * kr) * N + 32 * nb + 4 * nc;
    f32x4 v[8];
#pragma unroll
    for (int i = 0; i < 8; ++i) v[i] = *(const f32x4*)(src + (size_t)i * N);
    if (ks) { const f32x4 a = *(const f32x4*)(ks + 64 * kb + 8 * kr), b = *(const f32x4*)(ks + 64 * kb + 8 * kr + 4);
        v[0] *= a.x; v[1] *= a.y; v[2] *= a.z; v[3] *= a.w; v[4] *= b.x; v[5] *= b.y; v[6] *= b.z; v[7] *= b.w; }
    bf16* dst = WT + (size_t)(32 * nb + 4 * nc) * K + 64 * kb + 8 * kr;
#pragma unroll
    for (int e = 0; e < 4; ++e) { v4u o; o.x = pk2(v[0][e], v[1][e]); o.y = pk2(v[2][e], v[3][e]); o.z = pk2(v[4][e], v[5][e]); o.w = pk2(v[6][e], v[7][e]);
        *(GAS v4u*)(dst + (size_t)e * K) = o; }
}

struct Ptrs {
    const float *x, *p, *relb, *g_mix, *w_in, *pool_w, *pool_scale, *w_oa, *w_op, *w_out, *g_ffn, *rw, *rb, *w_gu, *b_gu, *w_d, *b_d, *g_ple, *w_pg, *w_pp, *g_fin;
    float* out; unsigned char* ws; gu32* ctl;
    bf16 *WinT, *WaT, *WcT, *WoutT, *WpgT, *WppT, *WguT, *WdT, *XB, *PB, *QKVU, *GATES, *PIN, *ATT, *TMP, *MERGED, *X1N, *XG, *H, *Y, *X2N, *PRJ, *VT, *ATT2;
    float *RSTD0, *KMEAN, *TOPW, *ROWW; int *TOPI, *INV;
};

__device__ __forceinline__ void p0_prologue(const Ptrs& P, LAS unsigned char* lds, int gw, int NGW, int wave, int lane) {
    constexpr int I_IN = 16 * 128, I_OA = 8 * 32, I_OUT = 16 * 32, I_PG = 16 * 32, I_PP = 4 * 32, I_GU1 = 16 * 64, I_D1 = 16 * 32;
    constexpr int I_GU = NE * I_GU1, I_D = NE * I_D1, NITEMS = I_IN + I_OA + I_OUT + I_PG + I_PP + I_GU + I_D;
    for (int it = gw; it < NITEMS; it += NGW) {
        int r = it;
        if (r < I_GU) { const int e = r / I_GU1; tr_item(P.w_gu + (size_t)e * D * 2048, D, 2048, P.g_ffn, P.WguT + (size_t)e * 2048 * D, r % I_GU1, lane); continue; } r -= I_GU;
        if (r < I_D) { const int e = r / I_D1; tr_item(P.w_d + (size_t)e * FF * D, FF, D, nullptr, P.WdT + (size_t)e * D * FF, r % I_D1, lane); continue; } r -= I_D;
        if (r < I_IN) { tr_item(P.w_in, D, INC, P.g_mix, P.WinT, r, lane); continue; } r -= I_IN;
        if (r < I_OA) { tr_item(P.w_oa, AW, D, nullptr, P.WaT, r, lane); continue; } r -= I_OA;
        if (r < I_OUT) { tr_item(P.w_out, D, D, nullptr, P.WoutT, r, lane); continue; } r -= I_OUT;
        if (r < I_PG) { tr_item(P.w_pg, D, D, P.g_ple, P.WpgT, r, lane); continue; } r -= I_PG;
        tr_item(P.w_pp, PLE, D, nullptr, P.WppT, r, lane);
    }
    for (int it = gw; it < 512 * 4; it += NGW) {
        const int k = it >> 2, n0 = (it & 3) * 256 + lane * 4, g = k >> 7;
        f32x4 a = {0.f, 0.f, 0.f, 0.f};
#pragma unroll 16
        for (int j = 0; j < 128; ++j) { const float s = P.pool_w[(size_t)k * 128 + j] * P.pool_scale[g * 128 + j]; const f32x4 w = *(const f32x4*)(P.w_op + (size_t)(g * 128 + j) * D + n0); a += w * s; }
#pragma unroll
        for (int i = 0; i < 4; ++i) P.WcT[(size_t)(n0 + i) * PW + k] = (bf16)f2bf(a[i]);
    }
    for (int m = gw; m < M; m += NGW) {
        const GAS f32x4* xr = (const GAS f32x4*)(P.x + (size_t)m * D) + lane; f32x4 v[4]; float s = 0.f;
#pragma unroll
        for (int j = 0; j < 4; ++j) { v[j] = xr[64 * j]; s += (v[j].x * v[j].x + v[j].y * v[j].y) + (v[j].z * v[j].z + v[j].w * v[j].w); }
        s = wave_sum(s); if (lane == 0) P.RSTD0[m] = 1.0f / sqrtf(s * (1.0f / D) + RMS_EPS);
        GAS unsigned long long* o8 = (GAS unsigned long long*)(P.XB + (size_t)m * D) + lane;
#pragma unroll
        for (int j = 0; j < 4; ++j) o8[64 * j] = (unsigned long long)pk2(v[j].x, v[j].y) | ((unsigned long long)pk2(v[j].z, v[j].w) << 32);
    }
    for (int i = gw * 64 + lane; i < M * PLE / 8; i += NGW * 64) { const f32x4 a = ((const f32x4*)P.p)[2 * i], b = ((const f32x4*)P.p)[2 * i + 1];
        v4u o; o.x = pk2(a.x, a.y); o.y = pk2(a.z, a.w); o.z = pk2(b.x, b.y); o.w = pk2(b.z, b.w); ((v4u*)P.PB)[i] = o; }
}

__device__ __forceinline__ void p2_kmean_pin(const Ptrs& P, LAS unsigned char* lds, int G, int tid, int gw, int NGW, int lane) {
    for (int it = blockIdx.x; it < BATCH * NBLK * NH; it += G) {
        const int h = it & 7, n = (it >> 3) & 31, b = it >> 8; LAS bf16* T = (LAS bf16*)lds;
#pragma unroll
        for (int i = 0; i < 4; ++i) { const int ch = tid + 512 * i, t = ch >> 3, c8 = ch & 7;
            const v4u w = *(const v4u*)(P.QKVU + (size_t)(b * SEQ + n * MOBA + t) * QP + 2 * AW + h * HD + c8 * 8);
            T[(c8 * 8 + 0) * 264 + t] = (bf16)(w.x & 0xffffu); T[(c8 * 8 + 1) * 264 + t] = (bf16)(w.x >> 16); T[(c8 * 8 + 2) * 264 + t] = (bf16)(w.y & 0xffffu); T[(c8 * 8 + 3) * 264 + t] = (bf16)(w.y >> 16);
            T[(c8 * 8 + 4) * 264 + t] = (bf16)(w.z & 0xffffu); T[(c8 * 8 + 5) * 264 + t] = (bf16)(w.z >> 16); T[(c8 * 8 + 6) * 264 + t] = (bf16)(w.w & 0xffffu); T[(c8 * 8 + 7) * 264 + t] = (bf16)(w.w >> 16); }
        __syncthreads();
#pragma unroll
        for (int i = 0; i < 4; ++i) { const int ch = tid + 512 * i, d = ch >> 5, cc = ch & 31;
            *(v4u*)(P.VT + ((size_t)(b * NH + h) * HD + d) * SEQ + n * MOBA + cc * 8) = *(const LAS v4u*)(T + d * 264 + cc * 8); }
        __syncthreads();
    }
    for (int it = gw; it < BATCH * NBLK * NH; it += NGW) {
        const int h = it & 7, n = (it >> 3) & 31, b = it >> 8;
        const bf16* kp = P.QKVU + (size_t)(b * SEQ + n * MOBA) * QP + AW + h * HD + lane; float s = 0.f;
#pragma unroll 8
        for (int i = 0; i < MOBA; ++i) s += bf2f(kp[(size_t)i * QP]);
        P.KMEAN[((size_t)(b * NH + h) * NBLK + n) * HD + lane] = s * (1.0f / MOBA);
    }
    for (int r = gw; r < M; r += NGW) {
        const int s = r & (SEQ - 1), g = lane >> 4, w = 2 << g; const int cnt = (s + 1 < w) ? s + 1 : w;
        const bf16* up = P.QKVU + (size_t)r * QP + 3 * AW + lane * 8; float a[8];
#pragma unroll
        for (int i = 0; i < 8; ++i) a[i] = 0.f;
        for (int i = 0; i < 16; ++i) if (i < cnt) { const v4u q = *(const v4u*)(up - (size_t)i * QP);
            a[0] += bflo(q.x); a[1] += bfhi(q.x); a[2] += bflo(q.y); a[3] += bfhi(q.y); a[4] += bflo(q.z); a[5] += bfhi(q.z); a[6] += bflo(q.w); a[7] += bfhi(q.w); }
        const v4u q = *(const v4u*)up; const float ic = 1.0f / (float)cnt;
        v4u o; o.x = pk2(a[0] * ic - bflo(q.x), a[1] * ic - bfhi(q.x)); o.y = pk2(a[2] * ic - bflo(q.y), a[3] * ic - bfhi(q.y));
        o.z = pk2(a[4] * ic - bflo(q.z), a[5] * ic - bfhi(q.z)); o.w = pk2(a[6] * ic - bflo(q.w), a[7] * ic - bfhi(q.w));
        *(v4u*)(P.PIN + (size_t)r * PW + lane * 8) = o;
    }
}

__device__ __forceinline__ int t5_bucket(int rel) {
    const int n = rel < 0 ? 0 : rel; if (n < 16) return n;
    int b = 16; b += (n >= 19); b += (n >= 21); b += (n >= 24); b += (n >= 27); b += (n >= 31); b += (n >= 35); b += (n >= 40); b += (n >= 46);
    b += (n >= 52); b += (n >= 59); b += (n >= 67); b += (n >= 77); b += (n >= 87); b += (n >= 99); b += (n >= 113); return b;
}

__device__ __forceinline__ void p3_attn_simple(const Ptrs& P, bf16* dst, int gw, int NGW, int lane) {
    const float NEG = -INFINITY;
    for (int idx = gw; idx < M * NH; idx += NGW) {
        const int t = idx >> 3, h = idx & 7, b = t >> 13, s = t & (SEQ - 1), j = s >> 8;
        const float qv = bf2f(P.QKVU[(size_t)t * QP + h * HD + lane]);
        float qs[64];
#pragma unroll
        for (int d = 0; d < 64; ++d) qs[d] = __builtin_bit_cast(float, __builtin_amdgcn_readlane(__builtin_bit_cast(int, qv), d));
        float g = NEG;
        if (lane < j) { const float* km = P.KMEAN + ((size_t)(b * NH + h) * NBLK + lane) * HD; float a = 0.f;
#pragma unroll
            for (int d = 0; d < 64; ++d) a += qs[d] * km[d];
            g = a; }
        int sel[3];
#pragma unroll
        for (int r = 0; r < 3; ++r) { const float mx = wave_max(g); const unsigned long long bal = __ballot(g == mx); const int ix = __ffsll((long long)bal) - 1; sel[r] = ix; if (lane == ix) g = NEG; }
        const int nvalid = j < 3 ? j : 3;
        float m = NEG, l = 0.f, o = 0.f;
        for (int pc = 0; pc <= nvalid; ++pc) {
            const int n = (pc == 0) ? j : (pc == 1 ? sel[0] : (pc == 2 ? sel[1] : sel[2]));
            const int nch = (pc == 0) ? (((s & 255) >> 6) + 1) : 4;
            for (int c = 0; c < nch; ++c) {
                const int key = n * MOBA + c * 64 + lane, rel = s - key;
                const v4u* kr = (const v4u*)(P.QKVU + (size_t)(b * SEQ + key) * QP + AW + h * HD);
                float sc = 0.f;
#pragma unroll
                for (int i = 0; i < 8; ++i) { const v4u w = kr[i];
                    sc += qs[8 * i] * bflo(w.x) + qs[8 * i + 1] * bfhi(w.x) + qs[8 * i + 2] * bflo(w.y) + qs[8 * i + 3] * bfhi(w.y) + qs[8 * i + 4] * bflo(w.z) + qs[8 * i + 5] * bfhi(w.z) + qs[8 * i + 6] * bflo(w.w) + qs[8 * i + 7] * bfhi(w.w); }
                sc += P.relb[t5_bucket(rel) * NH + h] * LOG2E; if (rel < 0) sc = NEG;
                const float cm = wave_max(sc), mn = fmaxf(m, cm);
                const float pr = __builtin_amdgcn_exp2f(sc - mn), al = __builtin_amdgcn_exp2f(m - mn);
                l = l * al + wave_sum(pr); o *= al; m = mn;
                const bf16* vb = P.QKVU + (size_t)(b * SEQ + n * MOBA + c * 64) * QP + 2 * AW + h * HD + lane;
#pragma unroll 16
                for (int kk = 0; kk < 64; ++kk) o += __builtin_bit_cast(float, __builtin_amdgcn_readlane(__builtin_bit_cast(int, pr), kk)) * bf2f(vb[(size_t)kk * QP]);
            }
        }
        dst[(size_t)t * AW + h * HD + lane] = (bf16)f2bf(o / l);
    }
}

__device__ __forceinline__ void p6_router(const Ptrs& P, LAS unsigned char* lds, int G, int tid, int wave, int lane) {
    LAS float* XS = (LAS float*)lds;
    LAS float* PART = (LAS float*)(lds + 65536);
    LAS float* LG = (LAS float*)(lds + 98304);
    LAS float* RS = (LAS float*)(lds + 100352);
    LAS unsigned* HIST = (LAS unsigned*)(lds + 100480);
    const int e = lane & 31, kq = lane >> 5, kbase = 128 * wave + 64 * kq;
    float wreg[64];
#pragma unroll
    for (int i = 0; i < 64; ++i) wreg[i] = P.rw[(size_t)(kbase + i) * NE + e] * P.g_ffn[kbase + i];
    for (int chunk = blockIdx.x; chunk < M / 64; chunk += G) {
        if (tid < 32) HIST[tid] = 0u;
        for (int bt = 0; bt < 4; ++bt) {
            __syncthreads();
#pragma unroll
            for (int tt = 0; tt < 2; ++tt) { const int tl = wave * 2 + tt, row = chunk * 64 + bt * 16 + tl;
                const GAS f32x4* xr = (const GAS f32x4*)(P.out + (size_t)row * D) + lane; f32x4 v[4]; float s = 0.f;
#pragma unroll
                for (int j = 0; j < 4; ++j) { v[j] = xr[64 * j]; s += (v[j].x * v[j].x + v[j].y * v[j].y) + (v[j].z * v[j].z + v[j].w * v[j].w); }
                s = wave_sum(s); const float rs = 1.0f / sqrtf(s * (1.0f / D) + RMS_EPS);
                GAS unsigned long long* o8 = (GAS unsigned long long*)(P.X1N + (size_t)row * D) + lane;
#pragma unroll
                for (int j = 0; j < 4; ++j) { *(LAS f32x4*)(XS + tl * 1024 + 4 * lane + 256 * j) = v[j];
                    o8[64 * j] = (unsigned long long)pk2(v[j].x * rs, v[j].y * rs) | ((unsigned long long)pk2(v[j].z * rs, v[j].w * rs) << 32); }
                if (lane == 0) RS[tl] = rs; }
            __syncthreads();
            for (int tl = 0; tl < 16; ++tl) { float a = 0.f;
#pragma unroll
                for (int i4 = 0; i4 < 16; ++i4) { const f32x4 xv = *(const LAS f32x4*)(XS + tl * 1024 + kbase + 4 * i4);
                    a += xv.x * wreg[4 * i4] + xv.y * wreg[4 * i4 + 1] + xv.z * wreg[4 * i4 + 2] + xv.w * wreg[4 * i4 + 3]; }
                PART[(tl * 16 + wave * 2 + kq) * 32 + e] = a; }
            __syncthreads();
            { const int tl = tid >> 5, ee = tid & 31; float a = 0.f;
#pragma unroll
                for (int q = 0; q < 16; ++q) a += PART[(tl * 16 + q) * 32 + ee];
                LG[tl * 32 + ee] = a * RS[tl] + P.rb[ee]; }
            __syncthreads();
            { const int tl = wave * 2 + kq, row = chunk * 64 + bt * 16 + tl; float v = LG[tl * 32 + e]; float tv[4]; int ti[4];
#pragma unroll
                for (int r = 0; r < 4; ++r) { float mx = v;
#pragma unroll
                    for (int o = 1; o < 32; o <<= 1) mx = fmaxf(mx, __shfl_xor(mx, o));
                    const unsigned long long bal = __ballot(v == mx); const unsigned hm = kq ? (unsigned)(bal >> 32) : (unsigned)bal; const int ix = __ffs((int)hm) - 1;
                    tv[r] = mx; ti[r] = ix; if (e == ix) v = -INFINITY; }
                const float e1 = __builtin_amdgcn_exp2f((tv[1] - tv[0]) * LOG2E), e2 = __builtin_amdgcn_exp2f((tv[2] - tv[0]) * LOG2E), e3 = __builtin_amdgcn_exp2f((tv[3] - tv[0]) * LOG2E);
                const float inv = 1.0f / (1.0f + e1 + e2 + e3);
                if (e == 0) { P.TOPI[row * 4 + 0] = ti[0]; P.TOPI[row * 4 + 1] = ti[1]; P.TOPI[row * 4 + 2] = ti[2]; P.TOPI[row * 4 + 3] = ti[3];
                    P.TOPW[row * 4 + 0] = inv; P.TOPW[row * 4 + 1] = e1 * inv; P.TOPW[row * 4 + 2] = e2 * inv; P.TOPW[row * 4 + 3] = e3 * inv;
                    __hip_atomic_fetch_add(HIST + ti[0], 1u, __ATOMIC_RELAXED, __HIP_MEMORY_SCOPE_WORKGROUP); __hip_atomic_fetch_add(HIST + ti[1], 1u, __ATOMIC_RELAXED, __HIP_MEMORY_SCOPE_WORKGROUP); __hip_atomic_fetch_add(HIST + ti[2], 1u, __ATOMIC_RELAXED, __HIP_MEMORY_SCOPE_WORKGROUP); __hip_atomic_fetch_add(HIST + ti[3], 1u, __ATOMIC_RELAXED, __HIP_MEMORY_SCOPE_WORKGROUP); } }
        }
        __syncthreads();
        if (tid < 32) P.ctl[CW_CNT + chunk * 32 + tid] = HIST[tid];
        __syncthreads();
    }
}

__device__ __forceinline__ void p7_permute(const Ptrs& P, LAS unsigned char* lds, int G, int tid, int wave, int lane) {
    LAS unsigned* SUMT = (LAS unsigned*)lds;
    LAS unsigned* SUMB = SUMT + 512;
    LAS unsigned* TOT = SUMB + 512;
    LAS unsigned* BASEP = TOT + 32; LAS unsigned* NTM = BASEP + 32; LAS unsigned* PST = NTM + 32;
    LAS unsigned* ES = PST + 32;
    LAS unsigned* POS = ES + 256;
    for (int chunk = blockIdx.x; chunk < M / 64; chunk += G) {
        { const int e = tid & 31, part = tid >> 5; unsigned st = 0u, sb = 0u;
            for (int c = 16 * part; c < 16 * part + 16; ++c) { const unsigned v = __hip_atomic_load(P.ctl + CW_CNT + c * 32 + e, RLX_AGENT); st += v; if (c < chunk) sb += v; }
            SUMT[part * 32 + e] = st; SUMB[part * 32 + e] = sb; }
        __syncthreads();
        if (tid < 32) { unsigned st = 0u, sb = 0u;
            for (int q = 0; q < 16; ++q) { st += SUMT[q * 32 + tid]; sb += SUMB[q * 32 + tid]; }
            TOT[tid] = st; BASEP[tid] = sb; NTM[tid] = (st + 255u) >> 8; }
        __syncthreads();
        if (tid < 32) { unsigned ps = 0u; for (int q = 0; q < tid; ++q) ps += NTM[q]; PST[tid] = ps * 256u; }
        if (tid < 256) ES[tid] = (unsigned)P.TOPI[(chunk * 64 + (tid >> 2)) * 4 + (tid & 3)];
        __syncthreads();
        if (tid < 256) { const unsigned e = ES[tid]; unsigned rank = 0u;
            for (int a = 0; a < tid; ++a) rank += (ES[a] == e) ? 1u : 0u;
            const unsigned pos = PST[e] + BASEP[e] + rank; const int ta = (chunk * 64 + (tid >> 2)) * 4 + (tid & 3);
            P.INV[ta] = (int)pos; P.ROWW[pos] = P.TOPW[ta]; POS[tid] = pos; }
        __syncthreads();
        for (int a = wave * 32; a < wave * 32 + 32; ++a) { const int tok = chunk * 64 + (a >> 2); const unsigned pos = POS[a];
            const v4u* src = (const v4u*)(P.X1N + (size_t)tok * D); v4u* dst = (v4u*)(P.XG + (size_t)pos * D);
            const v4u a0 = src[lane], a1 = src[lane + 64]; dst[lane] = a0; dst[lane + 64] = a1; }
        if (chunk < NE) { const unsigned r0 = PST[chunk] + TOT[chunk], r1 = PST[chunk] + NTM[chunk] * 256u;
            for (unsigned r = r0 + wave; r < r1; r += NWAVES) { v4u* dst = (v4u*)(P.XG + (size_t)r * D); const v4u z = {0u, 0u, 0u, 0u}; dst[lane] = z; dst[lane + 64] = z; if (lane == 0) P.ROWW[r] = 0.f; } }
        if (chunk == 0) { if (tid < 32) { const unsigned pm0 = PST[tid] >> 8; for (unsigned k = 0; k < NTM[tid]; ++k) { P.ctl[CW_TILES + 64 + 2 * (pm0 + k)] = pm0 + k; P.ctl[CW_TILES + 64 + 2 * (pm0 + k) + 1] = (unsigned)tid; } }
            if (tid == 0) P.ctl[CW_TILES] = (PST[31] >> 8) + NTM[31]; }
        __syncthreads();
    }
}

__device__ __forceinline__ void p10_combine(const Ptrs& P, int gw, int NGW, int lane) {
    for (int m = gw; m < M; m += NGW) {
        GAS f32x4* xr = (GAS f32x4*)(P.out + (size_t)m * D) + lane; f32x4 v[4];
#pragma unroll
        for (int j = 0; j < 4; ++j) v[j] = xr[64 * j];
#pragma unroll
        for (int k = 0; k < 4; ++k) { const int pos = P.INV[m * 4 + k]; const v2u* yr = (const v2u*)(P.Y + (size_t)pos * D) + lane;
#pragma unroll
            for (int j = 0; j < 4; ++j) { const v2u y = yr[64 * j]; v[j] += (f32x4){bflo(y.x), bfhi(y.x), bflo(y.y), bfhi(y.y)}; } }
        float s = 0.f;
#pragma unroll
        for (int j = 0; j < 4; ++j) s += (v[j].x * v[j].x + v[j].y * v[j].y) + (v[j].z * v[j].z + v[j].w * v[j].w);
        s = wave_sum(s); const float rs = 1.0f / sqrtf(s * (1.0f / D) + RMS_EPS);
        GAS unsigned long long* o8 = (GAS unsigned long long*)(P.X2N + (size_t)m * D) + lane;
#pragma unroll
        for (int j = 0; j < 4; ++j) { xr[64 * j] = v[j]; o8[64 * j] = (unsigned long long)pk2(v[j].x * rs, v[j].y * rs) | ((unsigned long long)pk2(v[j].z * rs, v[j].w * rs) << 32); }
    }
}

__device__ __forceinline__ void p12_final(const Ptrs& P, int gw, int NGW, int lane) {
    const GAS f32x4* gr = (const GAS f32x4*)P.g_fin + lane; f32x4 gv[4];
#pragma unroll
    for (int j = 0; j < 4; ++j) gv[j] = gr[64 * j];
    for (int m = gw; m < M; m += NGW) {
        GAS f32x4* xr = (GAS f32x4*)(P.out + (size_t)m * D) + lane; f32x4 v[4]; float s = 0.f;
#pragma unroll
        for (int j = 0; j < 4; ++j) { v[j] = xr[64 * j]; s += (v[j].x * v[j].x + v[j].y * v[j].y) + (v[j].z * v[j].z + v[j].w * v[j].w); }
        s = wave_sum(s); const float rs = 1.0f / sqrtf(s * (1.0f / D) + RMS_EPS);
#pragma unroll
        for (int j = 0; j < 4; ++j) xr[64 * j] = v[j] * rs * gv[j];
    }
}


namespace moba {
typedef short bf16x8 __attribute__((ext_vector_type(8)));
typedef float f32x16 __attribute__((ext_vector_type(16)));
typedef float f32x2_t __attribute__((ext_vector_type(2))); typedef __bf16 bf16x2_t __attribute__((ext_vector_type(2)));
constexpr int SO_ROW = 136;
constexpr int A_SO = 0, A_LSE = 3 * 256 * SO_ROW;
constexpr int A_LUT = A_LSE + 3072;
constexpr int A_PAIR = A_LUT + 3072;
constexpr int A_CNT = A_PAIR + 3072;
constexpr int A_OFF = A_CNT + 128;
constexpr int A_GRP = A_OFF + 128;
constexpr int A_NG = A_GRP + 1024;
constexpr int A_END = A_NG + 16;
static_assert(A_END <= RING_BYTES, "attention LDS");
constexpr float C2 = 0.125f * LOG2E;

__device__ __forceinline__ unsigned cvtpk(float lo, float hi) { f32x2_t v = {lo, hi}; bf16x2_t b = __builtin_convertvector(v, bf16x2_t); return __builtin_bit_cast(unsigned, b); }
__device__ __forceinline__ float xhalf_max(float m) { auto rr = __builtin_amdgcn_permlane32_swap(__float_as_uint(m), __float_as_uint(m), false, false); return fmaxf(__uint_as_float(rr[0]), __uint_as_float(rr[1])); }
__device__ __forceinline__ float xhalf_sum(float m) { auto rr = __builtin_amdgcn_permlane32_swap(__float_as_uint(m), __float_as_uint(m), false, false); return __uint_as_float(rr[0]) + __uint_as_float(rr[1]); }
#define MOBA_MFMA(a, b, c) __builtin_amdgcn_mfma_f32_32x32x16_bf16((a), (b), (c), 0, 0, 0)

struct FState { float m, l; f32x16 o0, o1; };

template <bool LUTMODE>
__device__ __forceinline__ void subtile(FState& st, const bf16x8 (&qr)[4], const bf16* kp, const bf16* vp, float cb, const LAS float* lut, int lidx) {
    bf16x8 kf[2][4], vf[2][2][2];
#pragma unroll
    for (int hf = 0; hf < 2; ++hf)
#pragma unroll
        for (int d0 = 0; d0 < 4; ++d0) kf[hf][d0] = *(const bf16x8*)(kp + (size_t)hf * 32 * QP + d0 * 16);
#pragma unroll
    for (int hf = 0; hf < 2; ++hf)
#pragma unroll
        for (int s = 0; s < 2; ++s)
#pragma unroll
            for (int db = 0; db < 2; ++db) vf[hf][s][db] = *(const bf16x8*)(vp + (size_t)db * 32 * SEQ + hf * 32 + s * 16);
    f32x16 p[2];
#pragma unroll
    for (int hf = 0; hf < 2; ++hf) {
#pragma unroll
        for (int r = 0; r < 16; ++r) p[hf][r] = LUTMODE ? 0.f : cb;
#pragma unroll
        for (int d0 = 0; d0 < 4; ++d0) p[hf] = MOBA_MFMA(kf[hf][d0], qr[d0], p[hf]);
    }
    if (LUTMODE) {
#pragma unroll
        for (int hf = 0; hf < 2; ++hf)
#pragma unroll
            for (int r = 0; r < 16; ++r) p[hf][r] += lut[lidx - (hf * 32 + (r & 7) + 16 * (r >> 3))];
    }
    float mx = fmaxf(p[0][0], p[1][0]);
#pragma unroll
    for (int r = 1; r < 16; ++r) mx = fmaxf(mx, fmaxf(p[0][r], p[1][r]));
    mx = xhalf_max(mx);
    const float mn = fmaxf(st.m, mx), al = __builtin_amdgcn_exp2f(st.m - mn);
    float rs = 0.f;
#pragma unroll
    for (int hf = 0; hf < 2; ++hf)
#pragma unroll
        for (int r = 0; r < 16; ++r) { p[hf][r] = __builtin_amdgcn_exp2f(p[hf][r] - mn); rs += p[hf][r]; }
    st.l = st.l * al + rs; st.m = mn;
#pragma unroll
    for (int r = 0; r < 16; ++r) { st.o0[r] *= al; st.o1[r] *= al; }
#pragma unroll
    for (int hf = 0; hf < 2; ++hf)
#pragma unroll
        for (int s = 0; s < 2; ++s) {
            v4u w; w.x = cvtpk(p[hf][8 * s], p[hf][8 * s + 1]); w.y = cvtpk(p[hf][8 * s + 2], p[hf][8 * s + 3]); w.z = cvtpk(p[hf][8 * s + 4], p[hf][8 * s + 5]); w.w = cvtpk(p[hf][8 * s + 6], p[hf][8 * s + 7]);
            const bf16x8 pb = __builtin_bit_cast(bf16x8, w);
            st.o0 = MOBA_MFMA(vf[hf][s][0], pb, st.o0); st.o1 = MOBA_MFMA(vf[hf][s][1], pb, st.o1);
        }
}

__device__ __forceinline__ void attn_unit(const Ptrs& P, LAS unsigned char* lds, int b, int h, int j, int tid, int wave, int lane) {
    const int c = lane & 31, hi = lane >> 5;
    LAS float* LSE = (LAS float*)(lds + A_LSE); LAS float* LUT = (LAS float*)(lds + A_LUT); LAS unsigned* PAIR = (LAS unsigned*)(lds + A_PAIR);
    LAS unsigned* CNT = (LAS unsigned*)(lds + A_CNT); LAS unsigned* OFF = (LAS unsigned*)(lds + A_OFF); LAS unsigned* GRP = (LAS unsigned*)(lds + A_GRP); LAS unsigned* NGW_ = (LAS unsigned*)(lds + A_NG);
    const size_t row0 = (size_t)b * SEQ;
    const bf16* Qb = P.QKVU + (row0 + (size_t)j * MOBA) * QP + h * HD;
    const bf16* Kb = P.QKVU + row0 * QP + AW + h * HD;
    const bf16* Vt = P.VT + (size_t)(b * NH + h) * HD * SEQ;
    const int kap = (c & 0x13) | ((c & 4) << 1) | ((c & 8) >> 1);
    const float NEG = -INFINITY;
    if (tid < 32) CNT[tid] = 0u;
    if (tid == 32) { NGW_[0] = 0u; NGW_[1] = 0u; }
    for (int i = tid; i < 768; i += NWAVES * 64) { const int rel = i - 256; LUT[i] = rel < 0 ? NEG : P.relb[t5_bucket(rel) * NH + h] * LOG2E; }
    __syncthreads();
    const float cb31 = LUT[256 + 200];
    const int nvalid = j < 3 ? j : 3;
    const int q_own = 32 * wave + c;
    bf16x8 qo[4];
#pragma unroll
    for (int d0 = 0; d0 < 4; ++d0) qo[d0] = *(const bf16x8*)(Qb + (size_t)q_own * QP + d0 * 16 + hi * 8);
    int sel0 = 0, sel1 = 0, sel2 = 0; unsigned rk0 = 0, rk1 = 0, rk2 = 0;
    if (j > 0) {
        f32x16 g;
#pragma unroll
        for (int r = 0; r < 16; ++r) g[r] = 0.f;
        const float* km = P.KMEAN + ((size_t)(b * NH + h) * NBLK + c) * HD + hi * 8;
#pragma unroll
        for (int d0 = 0; d0 < 4; ++d0) { const f32x4 a = *(const f32x4*)(km + d0 * 16), bq = *(const f32x4*)(km + d0 * 16 + 4);
            const float v[8] = {a.x, a.y, a.z, a.w, bq.x, bq.y, bq.z, bq.w}; unsigned wh[4], wl[4];
#pragma unroll
            for (int i = 0; i < 4; ++i) { const unsigned h0 = f2bf(v[2 * i]), h1 = f2bf(v[2 * i + 1]); wh[i] = h0 | (h1 << 16);
                wl[i] = f2bf(v[2 * i] - __uint_as_float(h0 << 16)) | (f2bf(v[2 * i + 1] - __uint_as_float(h1 << 16)) << 16); }
            const bf16x8 kh = __builtin_bit_cast(bf16x8, (v4u){wh[0], wh[1], wh[2], wh[3]}), kl = __builtin_bit_cast(bf16x8, (v4u){wl[0], wl[1], wl[2], wl[3]});
            g = MOBA_MFMA(kh, qo[d0], g); g = MOBA_MFMA(kl, qo[d0], g); }
#pragma unroll
        for (int r = 0; r < 16; ++r) { const int n = (r & 3) + 8 * (r >> 2) + 4 * hi; if (n >= j) g[r] = NEG; }
#pragma unroll
        for (int s = 0; s < 3; ++s) {
            float bv = g[0]; int bi = 4 * hi;
#pragma unroll
            for (int r = 1; r < 16; ++r) { const int n = (r & 3) + 8 * (r >> 2) + 4 * hi; if (g[r] > bv) { bv = g[r]; bi = n; } }
            const float pv = __shfl_xor(bv, 32); const int pi = __shfl_xor(bi, 32);
            if (pv > bv || (pv == bv && pi < bi)) { bv = pv; bi = pi; }
#pragma unroll
            for (int r = 0; r < 16; ++r) { const int n = (r & 3) + 8 * (r >> 2) + 4 * hi; if (n == bi) g[r] = NEG; }
            if (s == 0) sel0 = bi; else if (s == 1) sel1 = bi; else sel2 = bi;
        }
        if (hi == 0) {
            if (nvalid > 0) rk0 = __hip_atomic_fetch_add(CNT + sel0, 1u, __ATOMIC_RELAXED, __HIP_MEMORY_SCOPE_WORKGROUP);
            if (nvalid > 1) rk1 = __hip_atomic_fetch_add(CNT + sel1, 1u, __ATOMIC_RELAXED, __HIP_MEMORY_SCOPE_WORKGROUP);
            if (nvalid > 2) rk2 = __hip_atomic_fetch_add(CNT + sel2, 1u, __ATOMIC_RELAXED, __HIP_MEMORY_SCOPE_WORKGROUP);
        }
    }
    __syncthreads();
    if (wave == 0) {
        const unsigned cn = (lane < 32 && lane < j) ? CNT[lane & 31] : 0u; const unsigned ng = (cn + 31u) >> 5;
        unsigned po = cn, pg = ng;
#pragma unroll
        for (int o = 1; o < 32; o <<= 1) { const unsigned a = __shfl_up(po, o), bq = __shfl_up(pg, o); if ((lane & 31) >= o) { po += a; pg += bq; } }
        if (lane < 32) { OFF[lane] = po - cn; const unsigned g0 = pg - ng;
            for (unsigned k = 0; k < ng; ++k) { GRP[(g0 + k) * 4] = (unsigned)lane; GRP[(g0 + k) * 4 + 1] = po - cn + 32u * k; GRP[(g0 + k) * 4 + 2] = (cn - 32u * k) < 32u ? (cn - 32u * k) : 32u; }
            if (lane == 31) NGW_[0] = pg; }
    }
    __syncthreads();
    if (hi == 0 && j > 0) {
        if (nvalid > 0) PAIR[OFF[sel0] + rk0] = (unsigned)q_own;
        if (nvalid > 1) PAIR[OFF[sel1] + rk1] = (unsigned)q_own | (1u << 8);
        if (nvalid > 2) PAIR[OFF[sel2] + rk2] = (unsigned)q_own | (2u << 8);
    }
    __syncthreads();
    const unsigned NG = NGW_[0];
    for (;;) {
        unsigned gi = 0u; if (lane == 0) gi = __hip_atomic_fetch_add(NGW_ + 1, 1u, __ATOMIC_RELAXED, __HIP_MEMORY_SCOPE_WORKGROUP);
        gi = (unsigned)__builtin_amdgcn_readfirstlane((int)gi);
        if (gi >= NG) break;
        const int n = (int)GRP[gi * 4], first = (int)GRP[gi * 4 + 1], cnt = (int)GRP[gi * 4 + 2];
        const unsigned pr = PAIR[first + (c < cnt ? c : 0)]; const int q = (int)(pr & 255u), s = (int)(pr >> 8);
        bf16x8 qr[4];
#pragma unroll
        for (int d0 = 0; d0 < 4; ++d0) qr[d0] = *(const bf16x8*)(Qb + (size_t)q * QP + d0 * 16 + hi * 8);
        FState st; st.m = NEG; st.l = 0.f;
#pragma unroll
        for (int r = 0; r < 16; ++r) { st.o0[r] = 0.f; st.o1[r] = 0.f; }
        const bf16* kp = Kb + (size_t)(n * MOBA + kap) * QP + hi * 8; const bf16* vp = Vt + (size_t)c * SEQ + n * MOBA + hi * 8;
        if (n == j - 1) { const int lidx = (j * MOBA + q) - n * MOBA + 256 - 8 * hi;
            for (int kt = 0; kt < 4; ++kt) subtile<true>(st, qr, kp + (size_t)kt * 64 * QP, vp + kt * 64, 0.f, LUT, lidx - kt * 64);
        } else {
            for (int kt = 0; kt < 4; ++kt) subtile<false>(st, qr, kp + (size_t)kt * 64 * QP, vp + kt * 64, cb31, LUT, 0);
        }
        const float lt = xhalf_sum(st.l), il = 1.0f / lt;
        if (c < cnt) {
            LAS unsigned char* so = lds + A_SO + (s * 256 + q) * SO_ROW;
#pragma unroll
            for (int a = 0; a < 4; ++a) {
                v2u w0; w0.x = cvtpk(st.o0[4 * a] * il, st.o0[4 * a + 1] * il); w0.y = cvtpk(st.o0[4 * a + 2] * il, st.o0[4 * a + 3] * il);
                v2u w1; w1.x = cvtpk(st.o1[4 * a] * il, st.o1[4 * a + 1] * il); w1.y = cvtpk(st.o1[4 * a + 2] * il, st.o1[4 * a + 3] * il);
                *(LAS v2u*)(so + (8 * a + 4 * hi) * 2) = w0; *(LAS v2u*)(so + (32 + 8 * a + 4 * hi) * 2) = w1; }
            if (hi == 0) LSE[s * 256 + q] = st.m + __builtin_amdgcn_logf(lt);
        }
    }
    __syncthreads();
    {
        FState st; st.m = NEG; st.l = 0.f;
#pragma unroll
        for (int r = 0; r < 16; ++r) { st.o0[r] = 0.f; st.o1[r] = 0.f; }
        const bf16* kp = Kb + (size_t)(j * MOBA + kap) * QP + hi * 8; const bf16* vp = Vt + (size_t)c * SEQ + j * MOBA + hi * 8;
        const int lidx = q_own + 256 - 8 * hi; const int nkt = (wave >> 1) + 1;
        for (int kt = 0; kt < nkt; ++kt) subtile<true>(st, qo, kp + (size_t)kt * 64 * QP, vp + kt * 64, 0.f, LUT, lidx - kt * 64);
        const float lt = xhalf_sum(st.l); const float lse_own = st.m + __builtin_amdgcn_logf(lt);
        float ls0 = NEG, ls1 = NEG, ls2 = NEG;
        if (nvalid > 0) ls0 = LSE[q_own]; if (nvalid > 1) ls1 = LSE[256 + q_own]; if (nvalid > 2) ls2 = LSE[512 + q_own];
        const float Mx = fmaxf(fmaxf(lse_own, ls0), fmaxf(ls1, ls2));
        const float w0 = __builtin_amdgcn_exp2f(ls0 - Mx), w1 = __builtin_amdgcn_exp2f(ls1 - Mx), w2 = __builtin_amdgcn_exp2f(ls2 - Mx), wo = __builtin_amdgcn_exp2f(st.m - Mx);
        const float inv = 1.0f / (wo * lt + w0 + w1 + w2);
        bf16* op = P.ATT + (row0 + (size_t)j * MOBA + q_own) * AW + h * HD;
#pragma unroll
        for (int a = 0; a < 4; ++a)
#pragma unroll
            for (int db = 0; db < 2; ++db) {
                const int d = 32 * db + 8 * a + 4 * hi; float v[4];
#pragma unroll
                for (int i = 0; i < 4; ++i) v[i] = (db ? st.o1[4 * a + i] : st.o0[4 * a + i]) * wo;
                if (nvalid > 0) { const v2u t = *(const LAS v2u*)(lds + A_SO + (0 * 256 + q_own) * SO_ROW + d * 2); v[0] += w0 * bflo(t.x); v[1] += w0 * bfhi(t.x); v[2] += w0 * bflo(t.y); v[3] += w0 * bfhi(t.y); }
                if (nvalid > 1) { const v2u t = *(const LAS v2u*)(lds + A_SO + (1 * 256 + q_own) * SO_ROW + d * 2); v[0] += w1 * bflo(t.x); v[1] += w1 * bfhi(t.x); v[2] += w1 * bflo(t.y); v[3] += w1 * bfhi(t.y); }
                if (nvalid > 2) { const v2u t = *(const LAS v2u*)(lds + A_SO + (2 * 256 + q_own) * SO_ROW + d * 2); v[0] += w2 * bflo(t.x); v[1] += w2 * bfhi(t.x); v[2] += w2 * bflo(t.y); v[3] += w2 * bfhi(t.y); }
                v2u o; o.x = cvtpk(v[0] * inv, v[1] * inv); o.y = cvtpk(v[2] * inv, v[3] * inv);
                *(v2u*)(op + d) = o; }
    }
    __syncthreads();
}
__device__ __forceinline__ void attn_phase(const Ptrs& P, LAS unsigned char* lds, int vcu, int G, int tid, int wave, int lane) {
    for (int u = vcu; u < BATCH * NH * NBLK; u += G) {
        const int bh = (u & 255) >> 4, j = (u < 256) ? 31 - (u & 15) : (u & 15);
        attn_unit(P, lds, bh >> 3, bh & 7, j, tid, wave, lane);
    }
}
#undef MOBA_MFMA
}

struct Args { const float* in[21]; float* out; unsigned char* ws; int ph_lo, ph_hi; };
__global__ void __launch_bounds__(NWAVES * 64, 2) mk_fwd(Args args) {
    __shared__ __attribute__((aligned(16))) unsigned char lds_raw[LDS_BYTES];
    LAS unsigned char* lds = (LAS unsigned char*)lds_raw;
    volatile LAS unsigned* MISC = (volatile LAS unsigned*)(lds + MISC_OFF);
    const int wave = __builtin_amdgcn_readfirstlane((int)threadIdx.x >> 6);
#define LANE_TID const int lane = mk_lane_now(), tid = wave * 64 + lane; (void)tid; (void)lane
    const int G = gridDim.x; const int bx = blockIdx.x; const int vcu = (G % 8 == 0) ? (bx % 8) * (G / 8) + bx / 8 : bx;
    const int gw = vcu * NWAVES + wave, NGW = G * NWAVES;
    Ptrs P; unsigned char* ws = args.ws;
    P.x = args.in[0]; P.p = args.in[1]; P.relb = args.in[2]; P.g_mix = args.in[3]; P.w_in = args.in[4]; P.pool_w = args.in[5]; P.pool_scale = args.in[6]; P.w_oa = args.in[7];
    P.w_op = args.in[8]; P.w_out = args.in[9]; P.g_ffn = args.in[10]; P.rw = args.in[11]; P.rb = args.in[12]; P.w_gu = args.in[13]; P.b_gu = args.in[14]; P.w_d = args.in[15];
    P.b_d = args.in[16]; P.g_ple = args.in[17]; P.w_pg = args.in[18]; P.w_pp = args.in[19]; P.g_fin = args.in[20];
    P.out = args.out; P.ws = ws; P.ctl = (gu32*)(ws + WS_CTL);
    P.WinT = (bf16*)(ws + WS_WIN); P.WaT = (bf16*)(ws + WS_WA); P.WcT = (bf16*)(ws + WS_WC); P.WoutT = (bf16*)(ws + WS_WOUT); P.WpgT = (bf16*)(ws + WS_WPG); P.WppT = (bf16*)(ws + WS_WPP);
    P.WguT = (bf16*)(ws + WS_WGU); P.WdT = (bf16*)(ws + WS_WD); P.XB = (bf16*)(ws + WS_XB); P.PB = (bf16*)(ws + WS_PB); P.QKVU = (bf16*)(ws + WS_QKVU); P.GATES = (bf16*)(ws + WS_GATES);
    P.PIN = (bf16*)(ws + WS_PIN); P.ATT = (bf16*)(ws + WS_ATT); P.TMP = (bf16*)(ws + WS_TMP); P.MERGED = (bf16*)(ws + WS_MERGED); P.X1N = (bf16*)(ws + WS_X1N); P.XG = (bf16*)(ws + WS_XG);
    P.VT = (bf16*)(ws + WS_XG); P.ATT2 = (bf16*)(ws + WS_TMP); P.H = (bf16*)(ws + WS_H); P.Y = (bf16*)(ws + WS_Y); P.X2N = (bf16*)(ws + WS_X2N); P.PRJ = (bf16*)(ws + WS_PRJ);
    P.RSTD0 = (float*)(ws + WS_RSTD0); P.KMEAN = (float*)(ws + WS_KMEAN); P.TOPW = (float*)(ws + WS_TOPW); P.ROWW = (float*)(ws + WS_ROWW); P.TOPI = (int*)(ws + WS_TOPI); P.INV = (int*)(ws + WS_INV);

    { LANE_TID; for (int u = tid; u < (LDS_BYTES - RING_BYTES) / 4; u += NWAVES * 64) ((LAS unsigned*)(lds + RING_BYTES))[u] = 0u; }
    __syncthreads();
    XcdBarrier bar; bar.bar = (unsigned*)(P.ctl + CW_BAR); bar.x = 0; bar.st = nullptr;
    if (MK_N_LAUNCHES == 1) bar = xcd_barrier_post((unsigned*)(P.ctl + CW_BAR), MISC + 8);
    const int lo = args.ph_lo, hi = args.ph_hi;
#define IN(k) (lo <= (k) && (k) < hi)
#define SEAM(k) do { if (IN(k) && IN((k) + 1)) xcd_barrier(bar); } while (0)

    if (IN(0)) { LANE_TID; p0_prologue(P, lds, gw, NGW, wave, lane); }
#if MK_DUP_MASK & (1 << 0)
    if (IN(0)) { LANE_TID; p0_prologue(P, lds, gw, NGW, wave, lane); }
#endif
 SEAM(0);
    if (IN(1)) { pg8::Gemm g{P.XB, P.WinT, M, INC, D, wave}; pg8::StaticOrder S; S.init(M, INC, G, bx);
        mk::EpiInProj E{P.QKVU, P.GATES, P.RSTD0}; pg8::gemm_phase<mk::EpiInProj, pg8::StaticOrder, true, true>(lds, g, S, E); }
#if MK_DUP_MASK & (1 << 1)
    if (IN(1)) { pg8::Gemm g{P.XB, P.WinT, M, INC, D, wave}; pg8::StaticOrder S; S.init(M, INC, G, bx);
        mk::EpiInProj E{P.QKVU, P.GATES, P.RSTD0}; pg8::gemm_phase<mk::EpiInProj, pg8::StaticOrder, true, true>(lds, g, S, E); }
#endif
 SEAM(1);
    if (IN(2)) { LANE_TID; p2_kmean_pin(P, lds, G, tid, gw, NGW, lane); }
#if MK_DUP_MASK & (1 << 2)
    if (IN(2)) { LANE_TID; p2_kmean_pin(P, lds, G, tid, gw, NGW, lane); }
#endif
 SEAM(2);
    if (IN(3)) { LANE_TID;
#if MK_ATTN_SIMPLE
        p3_attn_simple(P, P.ATT, gw, NGW, lane);
#else
        moba::attn_phase(P, lds, vcu, G, tid, wave, lane);
#endif
    }
#if MK_DUP_MASK & (1 << 3)
    if (IN(3)) { LANE_TID;
#if MK_ATTN_SIMPLE
        p3_attn_simple(P, P.ATT, gw, NGW, lane);
#else
        moba::attn_phase(P, lds, vcu, G, tid, wave, lane);
#endif
    }
#endif
 SEAM(3);
    if (IN(4)) {
        { pg8::Gemm g{P.ATT, P.WaT, M, D, AW, wave}; pg8::StaticOrder S; S.init(M, D, G, bx);
          mk::EpiGateMul<false> E{P.GATES, 0, nullptr, P.TMP}; pg8::gemm_phase<mk::EpiGateMul<false>, pg8::StaticOrder, true, true>(lds, g, S, E); }
        VM_WAIT(); __syncthreads();
        { pg8::Gemm g{P.PIN, P.WcT, M, D, PW, wave}; pg8::StaticOrder S; S.init(M, D, G, bx);
          mk::EpiGateMul<true> E{P.GATES, D, P.TMP, P.MERGED}; pg8::gemm_phase<mk::EpiGateMul<true>, pg8::StaticOrder, true, true>(lds, g, S, E); }
    }
#if MK_DUP_MASK & (1 << 4)
    if (IN(4)) {
        { pg8::Gemm g{P.ATT, P.WaT, M, D, AW, wave}; pg8::StaticOrder S; S.init(M, D, G, bx);
          mk::EpiGateMul<false> E{P.GATES, 0, nullptr, P.TMP}; pg8::gemm_phase<mk::EpiGateMul<false>, pg8::StaticOrder, true, true>(lds, g, S, E); }
        VM_WAIT(); __syncthreads();
        { pg8::Gemm g{P.PIN, P.WcT, M, D, PW, wave}; pg8::StaticOrder S; S.init(M, D, G, bx);
          mk::EpiGateMul<true> E{P.GATES, D, P.TMP, P.MERGED}; pg8::gemm_phase<mk::EpiGateMul<true>, pg8::StaticOrder, true, true>(lds, g, S, E); }
    }
#endif
 SEAM(4);
    if (IN(5)) { pg8::Gemm g{P.MERGED, P.WoutT, M, D, D, wave}; pg8::StaticOrder S; S.init(M, D, G, bx);
        mk::EpiResF32 E{P.x, P.out}; pg8::gemm_phase<mk::EpiResF32, pg8::StaticOrder, true, true>(lds, g, S, E); }
#if MK_DUP_MASK & (1 << 5)
    if (IN(5)) { pg8::Gemm g{P.MERGED, P.WoutT, M, D, D, wave}; pg8::StaticOrder S; S.init(M, D, G, bx);
        mk::EpiResF32 E{P.x, P.out}; pg8::gemm_phase<mk::EpiResF32, pg8::StaticOrder, true, true>(lds, g, S, E); }
#endif
 SEAM(5);
    if (IN(6)) { LANE_TID; p6_router(P, lds, G, tid, wave, lane); }
#if MK_DUP_MASK & (1 << 6)
    if (IN(6)) { LANE_TID; p6_router(P, lds, G, tid, wave, lane); }
#endif
 SEAM(6);
    if (IN(7)) { LANE_TID; p7_permute(P, lds, G, tid, wave, lane); }
#if MK_DUP_MASK & (1 << 7)
    if (IN(7)) { LANE_TID; p7_permute(P, lds, G, tid, wave, lane); }
#endif
 SEAM(7);
    if (IN(8)) { pg8::Gemm g{P.XG, P.WguT, MAXROWS, NE * 2048, D, wave}; mk::MoeOrder S; S.init(P.ctl + CW_TILES, 8, G, bx);
        mk::EpiGlu E{P.b_gu, P.H}; pg8::gemm_phase<mk::EpiGlu, mk::MoeOrder, true, true>(lds, g, S, E); }
#if MK_DUP_MASK & (1 << 8)
    if (IN(8)) { pg8::Gemm g{P.XG, P.WguT, MAXROWS, NE * 2048, D, wave}; mk::MoeOrder S; S.init(P.ctl + CW_TILES, 8, G, bx);
        mk::EpiGlu E{P.b_gu, P.H}; pg8::gemm_phase<mk::EpiGlu, mk::MoeOrder, true, true>(lds, g, S, E); }
#endif
 SEAM(8);
    if (IN(9)) { pg8::Gemm g{P.H, P.WdT, MAXROWS, NE * D, FF, wave}; mk::MoeOrder S; S.init(P.ctl + CW_TILES, 4, G, bx);
        mk::EpiDown E{P.b_d, P.ROWW, P.Y}; pg8::gemm_phase<mk::EpiDown, mk::MoeOrder, true, true>(lds, g, S, E); }
#if MK_DUP_MASK & (1 << 9)
    if (IN(9)) { pg8::Gemm g{P.H, P.WdT, MAXROWS, NE * D, FF, wave}; mk::MoeOrder S; S.init(P.ctl + CW_TILES, 4, G, bx);
        mk::EpiDown E{P.b_d, P.ROWW, P.Y}; pg8::gemm_phase<mk::EpiDown, mk::MoeOrder, true, true>(lds, g, S, E); }
#endif
 SEAM(9);
    if (IN(10)) { LANE_TID; p10_combine(P, gw, NGW, lane); }
#if MK_DUP_MASK & (1 << 10)
    if (IN(10)) { LANE_TID; p10_combine(P, gw, NGW, lane); }
#endif
 SEAM(10);
    if (IN(11)) {
        { pg8::Gemm g{P.PB, P.WppT, M, D, PLE, wave}; pg8::StaticOrder S; S.init(M, D, G, bx);
          mk::EpiBf E{P.PRJ}; pg8::gemm_phase<mk::EpiBf, pg8::StaticOrder, true, true>(lds, g, S, E); }
        VM_WAIT(); __syncthreads();
        { pg8::Gemm g{P.X2N, P.WpgT, M, D, D, wave}; pg8::StaticOrder S; S.init(M, D, G, bx);
          mk::EpiPle E{P.out, P.PRJ}; pg8::gemm_phase<mk::EpiPle, pg8::StaticOrder, true, true>(lds, g, S, E); }
    }
#if MK_DUP_MASK & (1 << 11)
    if (IN(11)) {
        { pg8::Gemm g{P.PB, P.WppT, M, D, PLE, wave}; pg8::StaticOrder S; S.init(M, D, G, bx);
          mk::EpiBf E{P.PRJ}; pg8::gemm_phase<mk::EpiBf, pg8::StaticOrder, true, true>(lds, g, S, E); }
        VM_WAIT(); __syncthreads();
        { pg8::Gemm g{P.X2N, P.WpgT, M, D, D, wave}; pg8::StaticOrder S; S.init(M, D, G, bx);
          mk::EpiPle E{P.out, P.PRJ}; pg8::gemm_phase<mk::EpiPle, pg8::StaticOrder, true, true>(lds, g, S, E); }
    }
#endif
 SEAM(11);
    if (IN(12)) { LANE_TID; p12_final(P, gw, NGW, lane); }
#if MK_DUP_MASK & (1 << 12)
    if (IN(12)) { LANE_TID; p12_final(P, gw, NGW, lane); }
#endif
#undef IN
#undef SEAM
}

extern "C" void kernel_launch(void* const* d_in, const int* in_sizes, int n_in, void* d_out, int out_size, void* d_ws, size_t ws_size, hipStream_t stream) {
    static int grid = 0;
    if (grid == 0) {
        if (n_in != 21 || in_sizes[0] != M * D || out_size != M * D || ws_size < WS_END) { fprintf(stderr, "kernel_launch: unexpected shapes (n_in %d, in0 %d, out %d, ws %zu)\n", n_in, n_in > 0 ? in_sizes[0] : -1, out_size, ws_size); grid = -1; return; }
        int dev = 0, cus = 0;
        if (hipGetDevice(&dev) != hipSuccess || hipDeviceGetAttribute(&cus, hipDeviceAttributeMultiprocessorCount, dev) != hipSuccess) { grid = -1; return; }
        grid = cus;
    }
    if (grid < 0) return;
    (void)hipMemsetAsync((char*)d_ws + WS_CTL, 0, CTL_ZERO_BYTES, stream);
    Args a{};
    for (int i = 0; i < 21; ++i) a.in[i] = (const float*)d_in[i];
    a.out = (float*)d_out; a.ws = (unsigned char*)d_ws;
    if (MK_N_LAUNCHES == 1) { a.ph_lo = 0; a.ph_hi = NPH; hipLaunchKernelGGL(mk_fwd, dim3(grid), dim3(NWAVES * 64), 0, stream, a); }
    else for (int k = 0; k < NPH; ++k) { a.ph_lo = k; a.ph_hi = k + 1; hipLaunchKernelGGL(mk_fwd, dim3(grid), dim3(NWAVES * 64), 0, stream, a); }
}
```

```cpp
#include <hip/hip_runtime.h>
#include <cstdio>
#include <cstdint>
__device__ __forceinline__ int mk_lane_now() { int l; asm volatile("v_mbcnt_lo_u32_b32 %0, -1, 0\n\tv_mbcnt_hi_u32_b32 %0, -1, %0" : "=v"(l)); return l; }
namespace pg8 {
#define PG8_LAS __attribute__((address_space(3)))
typedef unsigned short bf16_t;
typedef short bf16x8 __attribute__((ext_vector_type(8)));
typedef float f32x4 __attribute__((ext_vector_type(4)));
typedef unsigned u32x4 __attribute__((ext_vector_type(4)));
constexpr int BM = 256, BK = 64, HALF = 128, HTB = HALF * BK * 2  , STAGE_BYTES = 8 * HTB, NXCD = 8, WGM = 8;

__host__ __device__ __forceinline__ int lds_byte(int r, int c) { const int st = (r >> 4) * 2 + (c >> 5), rr = r & 15, cc = c & 31, ob = rr * 64 + cc * 2; return st * 1024 + (ob ^ (((ob >> 9) & 1) << 5)); }
__host__ __device__ __forceinline__ void stage_rc(int b, int& R, int& C) { const int st = b / 1024, sb = b % 1024, swz = sb ^ (((sb >> 9) & 1) << 5); R = (st >> 1) * 16 + swz / 64; C = (st & 1) * 32 + (swz % 64) / 2; }
__host__ __device__ __forceinline__ int perm32(int rho) { const int n = rho >> 4, i = rho & 15; return 8 * (i >> 2) + 4 * n + (i & 3); }

struct Unit { int pm, pn; };
struct Gemm { const bf16_t* A; const bf16_t* Bt; int M, N, K, wid; };

struct StaticOrder {
    int nM, nN, nwg, G, c;
    __host__ __device__ void init(int M, int N, int G_, int c_) { nM = M / BM; nN = N / BM; nwg = nM * nN; G = G_; c = c_; }
    __host__ __device__ bool next(int i, Unit& u) const {
        const long L = (long)i * G + c; if (L >= nwg) return false;
        int wgid = (int)L; { const int q = nwg / NXCD, r = nwg % NXCD, xcd = wgid % NXCD, off = wgid / NXCD; wgid = (xcd < r ? xcd * (q + 1) : r * (q + 1) + (xcd - r) * q) + off; }
        const int nig = WGM * nN, gid = wgid / nig, fm = gid * WGM, gsz = (nM - fm) < WGM ? (nM - fm) : WGM;
        u.pm = fm + ((wgid % nig) % gsz); u.pn = (wgid % nig) / gsz; return true;
    }
    __device__ __forceinline__ void a_ready(const Unit&) const {}
    __device__ __forceinline__ void done(const Unit&) const {}
};
__device__ __forceinline__ unsigned cvt_pk_bf16(float lo, float hi) { unsigned r; asm volatile("v_cvt_pk_bf16_f32 %0, %1, %2" : "=v"(r) : "v"(lo), "v"(hi)); return r; }
typedef int pg8_v8i __attribute__((ext_vector_type(8))); typedef int pg8_v4i __attribute__((ext_vector_type(4)));
__device__ __forceinline__ pg8_v8i cat8(bf16x8 a, bf16x8 b) { return __builtin_shufflevector(__builtin_bit_cast(pg8_v4i, a), __builtin_bit_cast(pg8_v4i, b), 0, 1, 2, 3, 4, 5, 6, 7); }
template <class Epi, class Sched, bool ALIGN_EPI = false, bool SP2 = false, bool FP8 = false>
__device__ __forceinline__ void gemm_phase(PG8_LAS unsigned char* lds, const Gemm g, const Sched& S, const Epi& E) {
    const int wid = g.wid, lane = mk_lane_now(), tid = wid * 64 + lane, wr = wid >> 2, wc = wid & 3, fr = lane & 15, fq = lane >> 4;
    int K_ = g.K; asm volatile("" : "+s"(K_)); const int K = K_, nt = K / BK;
    unsigned voffA[2], voffB[2];
#pragma unroll
    for (int i = 0; i < 2; ++i) { int R, C; stage_rc(tid * 16 + i * 8192, R, C); const int Rb = Epi::PERM ? ((R & ~31) + perm32(R & 31)) : R;
        voffA[i] = (unsigned)(R * K + C) * 2u; voffB[i] = (unsigned)(Rb * K + C) * 2u; }
    const size_t kstep = (size_t)(BK * 2);
    const size_t hstep = (size_t)HALF * K * 2;
    const size_t tstep = 2 * hstep;
    const unsigned ldsw = (unsigned)wid * 1024u;
    const int aoff = lds_byte(wr * 64 + fr, fq * 8), boff = lds_byte(wc * 32 + fr, fq * 8);
#define PG8_SA(b, h) (((b) * 2 + (h)) * HTB)
#define PG8_SB(b, h) ((4 + (b) * 2 + (h)) * HTB)
#define PG8_STAGE(bufoff, gbase, voff) do { _Pragma("unroll") for (int _i = 0; _i < 2; ++_i) \
        __builtin_amdgcn_global_load_lds((const unsigned*)((const char*)(gbase) + (voff)[_i]), (PG8_LAS unsigned*)(lds + (bufoff) + ldsw + _i * 8192), 16, 0, 0); } while (0)
#define PG8_LDA(dst, b, h) do { if constexpr (FP8) { _Pragma("unroll") for (int m = 0; m < 4; ++m) dst##8[m] = cat8(*(const PG8_LAS bf16x8*)(lds + PG8_SA(b, h) + aoff + m * 2048), *(const PG8_LAS bf16x8*)(lds + PG8_SA(b, h) + aoff + m * 2048 + 1024)); } else { \
        _Pragma("unroll") for (int m = 0; m < 4; ++m) _Pragma("unroll") for (int k = 0; k < 2; ++k) dst[m][k] = *(const PG8_LAS bf16x8*)(lds + PG8_SA(b, h) + aoff + m * 2048 + k * 1024); } } while (0)
#define PG8_LDB(dst, b, h) do { if constexpr (FP8) { _Pragma("unroll") for (int n = 0; n < 2; ++n) dst##8[n] = cat8(*(const PG8_LAS bf16x8*)(lds + PG8_SB(b, h) + boff + n * 2048), *(const PG8_LAS bf16x8*)(lds + PG8_SB(b, h) + boff + n * 2048 + 1024)); } else { \
        _Pragma("unroll") for (int n = 0; n < 2; ++n) _Pragma("unroll") for (int k = 0; k < 2; ++k) dst[n][k] = *(const PG8_LAS bf16x8*)(lds + PG8_SB(b, h) + boff + n * 2048 + k * 1024); } } while (0)
#define PG8_MMA(ai, bj, At, Bt) do { __builtin_amdgcn_s_setprio(1); if constexpr (FP8) { _Pragma("unroll") for (int m = 0; m < 4; ++m) _Pragma("unroll") for (int n = 0; n < 2; ++n) \
        asm volatile("v_mfma_scale_f32_16x16x128_f8f6f4 %0, %1, %2, %0, %3, %3 op_sel_hi:[0,0,0]" : "+v"(acc[ai][bj][m][n]) : "v"(Bt##8[n]), "v"(At##8[m]), "v"(f8_unit_scale)); } else { \
        _Pragma("unroll") for (int m = 0; m < 4; ++m) _Pragma("unroll") for (int n = 0; n < 2; ++n) _Pragma("unroll") for (int k = 0; k < 2; ++k) \
        acc[ai][bj][m][n] = __builtin_amdgcn_mfma_f32_16x16x32_bf16(Bt[n][k], At[m][k], acc[ai][bj][m][n], 0, 0, 0); } __builtin_amdgcn_s_setprio(0); } while (0)
#define PG8_WAIT_V(n) asm volatile("s_waitcnt vmcnt(" #n ")" ::: "memory")
#define PG8_WAIT_L(n) asm volatile("s_waitcnt lgkmcnt(" #n ")" ::: "memory")
#define PG8_BAR __builtin_amdgcn_s_barrier()
#define PG8_SCHED __builtin_amdgcn_sched_barrier(0)
    Unit cur, nxt; int ui = 0;
    if (!S.next(0, cur)) return;
    f32x4 acc[2][2][4][2];
#pragma unroll
    for (int a = 0; a < 2; ++a)
#pragma unroll
        for (int b = 0; b < 2; ++b)
#pragma unroll
            for (int m = 0; m < 4; ++m)
#pragma unroll
                for (int n = 0; n < 2; ++n) acc[a][b][m][n] = (f32x4){0.f, 0.f, 0.f, 0.f};
    bf16x8 At[4][2], B0[2][2], B1[2][2]; pg8_v8i At8[4], B08[2], B18[2]; int f8_unit_scale = 0x7f7f7f7f; asm volatile("" : "+v"(f8_unit_scale));
    const char* cA = (const char*)g.A + (size_t)cur.pm * tstep; const char* cB = (const char*)g.Bt + (size_t)cur.pn * tstep;
    S.a_ready(cur);
    if constexpr (SP2) {
        PG8_STAGE(PG8_SB(0, 0), cB, voffB); PG8_STAGE(PG8_SB(0, 1), cB + hstep, voffB); PG8_STAGE(PG8_SA(0, 0), cA, voffA); PG8_STAGE(PG8_SA(0, 1), cA + hstep, voffA);
        if (wr == 1) PG8_BAR;
        PG8_WAIT_V(2); PG8_BAR;
        PG8_STAGE(PG8_SB(1, 0), cB + kstep, voffB); PG8_STAGE(PG8_SA(1, 0), cA + kstep, voffA); PG8_STAGE(PG8_SB(1, 1), cB + hstep + kstep, voffB);
        PG8_WAIT_V(6); PG8_BAR;
    } else {
        PG8_STAGE(PG8_SB(0, 0), cB, voffB); PG8_STAGE(PG8_SA(0, 0), cA, voffA); PG8_STAGE(PG8_SB(0, 1), cB + hstep, voffB); PG8_STAGE(PG8_SA(0, 1), cA + hstep, voffA);
        if (wr == 1) PG8_BAR;
        PG8_WAIT_V(4); PG8_BAR;
        PG8_STAGE(PG8_SB(1, 0), cB + kstep, voffB); PG8_STAGE(PG8_SA(1, 0), cA + kstep, voffA); PG8_STAGE(PG8_SB(1, 1), cB + hstep + kstep, voffB);
        PG8_WAIT_V(6); PG8_BAR;
    }
    for (;;) {
        const bool has_next = S.next(ui + 1, nxt);
        const char* nA = has_next ? (const char*)g.A + (size_t)nxt.pm * tstep : cA; const char* nB = has_next ? (const char*)g.Bt + (size_t)nxt.pn * tstep : cB;
        for (int t = 0; t < nt; t += 2) {
            const bool last = (t == nt - 2);
            const char* a1 = cA + (size_t)(t + 1) * kstep;
            const char* a2 = last ? nA : cA + (size_t)(t + 2) * kstep; const char* b2 = last ? nB : cB + (size_t)(t + 2) * kstep;
            const char* a3 = a2 + kstep; const char* b3 = b2 + kstep;
            if (last && has_next) S.a_ready(nxt);
            if constexpr (SP2) {
            PG8_LDB(B0, 0, 0); PG8_LDB(B1, 0, 1); PG8_SCHED; PG8_LDA(At, 0, 0); PG8_STAGE(PG8_SA(1, 1), a1 + hstep, voffA);
            PG8_WAIT_V(8); PG8_WAIT_L(0); PG8_BAR; PG8_MMA(0, 0, At, B0); PG8_MMA(0, 1, At, B1); PG8_BAR; PG8_SCHED;
            PG8_LDA(At, 0, 1); PG8_STAGE(PG8_SB(0, 0), b2, voffB); PG8_STAGE(PG8_SB(0, 1), b2 + hstep, voffB); PG8_STAGE(PG8_SA(0, 0), a2, voffA);
            PG8_WAIT_V(8); PG8_WAIT_L(0); PG8_BAR; PG8_MMA(1, 0, At, B0); PG8_MMA(1, 1, At, B1); PG8_BAR; PG8_SCHED;
            PG8_LDB(B0, 1, 0); PG8_LDB(B1, 1, 1); PG8_SCHED; PG8_LDA(At, 1, 0); PG8_STAGE(PG8_SA(0, 1), a2 + hstep, voffA);
            PG8_WAIT_V(8); PG8_WAIT_L(0); PG8_BAR; PG8_MMA(0, 0, At, B0); PG8_MMA(0, 1, At, B1); PG8_BAR; PG8_SCHED;
            PG8_LDA(At, 1, 1); PG8_STAGE(PG8_SB(1, 0), b3, voffB); PG8_STAGE(PG8_SB(1, 1), b3 + hstep, voffB); PG8_STAGE(PG8_SA(1, 0), a3, voffA);
            PG8_WAIT_V(8); PG8_WAIT_L(0); PG8_BAR; PG8_MMA(1, 0, At, B0); PG8_MMA(1, 1, At, B1); PG8_BAR; PG8_SCHED;
            } else {
            PG8_LDB(B0, 0, 0); PG8_SCHED; PG8_LDA(At, 0, 0); PG8_STAGE(PG8_SA(1, 1), a1 + hstep, voffA);
            PG8_WAIT_L(8); PG8_BAR; PG8_WAIT_L(0); PG8_MMA(0, 0, At, B0); PG8_BAR; PG8_SCHED;
            PG8_LDB(B1, 0, 1); PG8_STAGE(PG8_SB(0, 0), b2, voffB);
            PG8_BAR; PG8_WAIT_L(0); PG8_MMA(0, 1, At, B1); PG8_BAR;
            PG8_LDA(At, 0, 1); PG8_STAGE(PG8_SA(0, 0), a2, voffA);
            PG8_BAR; PG8_WAIT_L(0); PG8_MMA(1, 0, At, B0); PG8_BAR; PG8_SCHED;
            PG8_STAGE(PG8_SB(0, 1), b2 + hstep, voffB);
            PG8_WAIT_V(6); PG8_BAR; PG8_MMA(1, 1, At, B1); PG8_BAR;
            PG8_LDB(B0, 1, 0); PG8_SCHED; PG8_LDA(At, 1, 0); PG8_STAGE(PG8_SA(0, 1), a2 + hstep, voffA);
            PG8_WAIT_L(8); PG8_BAR; PG8_WAIT_L(0); PG8_MMA(0, 0, At, B0); PG8_BAR; PG8_SCHED;
            PG8_LDB(B1, 1, 1); PG8_STAGE(PG8_SB(1, 0), b3, voffB);
            PG8_BAR; PG8_WAIT_L(0); PG8_MMA(0, 1, At, B1); PG8_BAR;
            PG8_LDA(At, 1, 1); PG8_STAGE(PG8_SA(1, 0), a3, voffA);
            PG8_BAR; PG8_WAIT_L(0); PG8_MMA(1, 0, At, B0); PG8_BAR; PG8_SCHED;
            PG8_STAGE(PG8_SB(1, 1), b3 + hstep, voffB);
            PG8_WAIT_V(6); PG8_BAR; PG8_MMA(1, 1, At, B1); PG8_BAR;
            }
        }
        if constexpr (ALIGN_EPI) { if (wr == 0) PG8_BAR; }
        if constexpr (FP8) asm volatile("s_nop 15\n\ts_nop 7" ::: "memory");
        if constexpr (!Epi::AFTER_DRAIN) { E(acc, cur, wr, wc, fr, fq); S.done(cur); }
        if (!has_next) break;
#pragma unroll
        for (int a = 0; a < 2; ++a)
#pragma unroll
            for (int b = 0; b < 2; ++b)
#pragma unroll
                for (int m = 0; m < 4; ++m)
#pragma unroll
                    for (int n = 0; n < 2; ++n) acc[a][b][m][n] = (f32x4){0.f, 0.f, 0.f, 0.f};
        cur = nxt; cA = nA; cB = nB; ++ui;
        if constexpr (ALIGN_EPI) { if (wr == 1) PG8_BAR; }
    }
    PG8_WAIT_V(0);
    if constexpr (!ALIGN_EPI) { if (wr == 0) PG8_BAR; }
    PG8_BAR;
    if constexpr (Epi::AFTER_DRAIN) { E.fused(acc, cur, wr, wc, fr, fq, lds, wid, lane); S.done(cur); }
#undef PG8_SA
#undef PG8_SB
#undef PG8_STAGE
#undef PG8_LDA
#undef PG8_LDB
#undef PG8_MMA
#undef PG8_WAIT_V
#undef PG8_WAIT_L
#undef PG8_BAR
#undef PG8_SCHED
}
}
#define GAS __attribute__((address_space(1)))
#define LAS __attribute__((address_space(3)))
#define XB_TMO      128
#define XB_XCNT(j)  (256  + 64 * (j))
#define XB_XSUB(j)  (1280 + 64 * (j))
#define XB_XGEN(j)  (2304 + 64 * (j))
#define XB_TOP      3328
#define XB_TOPGEN   3392
#define XCD_BAR_WORDS 3456
#define XB_SPIN_CAP (1u << 18)

__device__ __forceinline__ unsigned xb_ld(unsigned* p)              { return __hip_atomic_load(p, __ATOMIC_RELAXED, __HIP_MEMORY_SCOPE_AGENT); }
__device__ __forceinline__ unsigned xb_add(unsigned* p, unsigned v) { return __hip_atomic_fetch_add(p, v, __ATOMIC_RELAXED, __HIP_MEMORY_SCOPE_AGENT); }
__device__ __forceinline__ unsigned xb_xcc_id() { return (unsigned)__builtin_amdgcn_s_getreg((3 << 11) | 20) & 0xFu; }
#define XB_SPIN(cond, bar) do { unsigned _sp = 0; while (cond) { __builtin_amdgcn_s_sleep(1); \
    if ((++_sp & 255u) == 0u) { if (xb_ld(&(bar)[XB_TMO])) break; if (_sp > XB_SPIN_CAP) { atomicAdd(&(bar)[XB_TMO], 1u); break; } } } } while (0)

struct XcdBarrier {
    unsigned* bar; unsigned x;
    volatile LAS unsigned* st;
};

__device__ __forceinline__ XcdBarrier xcd_barrier_post(unsigned* bar, volatile LAS unsigned* st) {
    XcdBarrier b; b.bar = bar; b.x = xb_xcc_id(); b.st = st;
    if (threadIdx.x == 0) (void)xb_add(&bar[XB_XCNT(b.x)], 1u);
    return b;
}
__device__ __forceinline__ void xcd_barrier_complete(unsigned* bar, unsigned x, unsigned& nloc, unsigned& nx) {
    const unsigned G = gridDim.x * gridDim.y * gridDim.z;
    unsigned sum, cnt, mine, sp = 0u;
    for (;;) {
        sum = 0u; cnt = 0u; mine = 0u;
#pragma unroll
        for (unsigned j = 0; j < 16; ++j) { const unsigned c = xb_ld(&bar[XB_XCNT(j)]); sum += c; cnt += (c > 0u) ? 1u : 0u; mine = (j == x) ? c : mine; }
        if (sum == G) break;
        __builtin_amdgcn_s_sleep(1);
        if ((++sp & 255u) == 0u) { if (xb_ld(&bar[XB_TMO])) break; if (sp > XB_SPIN_CAP) { atomicAdd(&bar[XB_TMO], 1u); break; } }
    }
    nloc = mine > 0u ? mine : 1u; nx = cnt > 0u ? cnt : 1u;
}

__device__ __forceinline__ void xcd_barrier(const XcdBarrier& b) {
    asm volatile("s_waitcnt vmcnt(0)" ::: "memory");
    __syncthreads();
    if (threadIdx.x == 0) {
        unsigned* bar = b.bar;
        __builtin_amdgcn_s_waitcnt(0);
        unsigned nloc = b.st[0], nx = b.st[1];
        if (nloc == 0u) { xcd_barrier_complete(bar, b.x, nloc, nx); b.st[0] = nloc; b.st[1] = nx; }
        const unsigned old = xb_add(&bar[XB_XSUB(b.x)], 1u);
        const unsigned gen = old / nloc;
        if (old + 1u == (gen + 1u) * nloc) {
            __builtin_amdgcn_fence(__ATOMIC_RELEASE, "agent");
            asm volatile("s_waitcnt vmcnt(0)" ::: "memory");
            const unsigned og = xb_add(&bar[XB_TOP], 1u);
            const unsigned tg = og / nx;
            if (og + 1u == (tg + 1u) * nx) xb_add(&bar[XB_TOPGEN], 1u);
            else XB_SPIN(xb_ld(&bar[XB_TOPGEN]) == tg, bar);
            __builtin_amdgcn_fence(__ATOMIC_ACQUIRE, "agent");
            xb_add(&bar[XB_XGEN(b.x)], 1u);
            asm volatile("s_waitcnt vmcnt(0)" ::: "memory");
        } else {
            XB_SPIN(xb_ld(&bar[XB_XGEN(b.x)]) == gen, bar);
            __builtin_amdgcn_fence(__ATOMIC_ACQUIRE, "agent");
            asm volatile("s_waitcnt vmcnt(0)" ::: "memory");
        }
    }
    __syncthreads();
}

#ifndef MK_ATTN_SIMPLE
#define MK_ATTN_SIMPLE 0
#endif
#ifndef MK_DUP_MASK
#define MK_DUP_MASK 0
#endif
#ifndef MK_N_LAUNCHES
#define MK_N_LAUNCHES 1
#endif
constexpr int NWAVES = 8;
constexpr int BATCH = 2, SEQ = 8192, D = 1024, M = BATCH * SEQ;
constexpr int NH = 8, HD = 64, AW = 512, PW = 512, INC = 4096;
constexpr int NE = 32, FF = 1024, PLE = 256, MOBA = 256, NBLK = SEQ / MOBA;
constexpr int QP = 2048;
constexpr int MAXROWS = M * 4 + NE * 256;
constexpr float RMS_EPS = 1e-6f;
constexpr float LOG2E = 1.4426950408889634f;
constexpr int NPH = 13;
constexpr float W8_SCALE = 32.0f, W8_INV = 1.0f / 32.0f;

constexpr size_t MiB = 1u << 20;
constexpr size_t WS_CTL = 0, CTL_ZERO_BYTES = 1 * MiB;
constexpr size_t WS_WIN = 2 * MiB, WS_WA = 10 * MiB, WS_WC = 11 * MiB, WS_WOUT = 12 * MiB, WS_WPG = 14 * MiB, WS_WPP = 16 * MiB;
constexpr size_t WS_RSTD0 = 17 * MiB, WS_KMEAN = WS_RSTD0 + 256 * 1024, WS_TOPI = WS_KMEAN + 256 * 1024, WS_TOPW = WS_TOPI + 256 * 1024;
constexpr size_t WS_INV = 18 * MiB, WS_ROWW = WS_INV + 256 * 1024;
constexpr size_t WS_WGU = 32 * MiB, WS_WD = 160 * MiB, WS_XB = 224 * MiB, WS_PB = 256 * MiB, WS_QKVU = 264 * MiB, WS_GATES = 328 * MiB;
constexpr size_t WS_PIN = 392 * MiB, WS_ATT = 408 * MiB, WS_TMP = 424 * MiB, WS_MERGED = 456 * MiB, WS_X1N = 488 * MiB;
constexpr size_t WS_XG = 520 * MiB, WS_H = 664 * MiB, WS_Y = 808 * MiB, WS_X2N = 952 * MiB, WS_PRJ = 984 * MiB, WS_END = 1016 * MiB;
static_assert(WS_ROWW + (size_t)MAXROWS * 4 <= 19 * MiB && WS_XG + (size_t)MAXROWS * 1024 * 2 <= WS_H && WS_Y + (size_t)MAXROWS * 1024 * 2 <= WS_X2N, "d_ws map");
constexpr int CW_TMO = 0, CW_CODE = 1, CW_BAR = 4096, CW_CNT = 16384, CW_TILES = 32768;
constexpr int LDS_BYTES = 147456, RING_BYTES = 131072, MISC_OFF = RING_BYTES + 320;

typedef unsigned short bf16;
typedef unsigned v4u __attribute__((ext_vector_type(4)));
typedef unsigned v2u __attribute__((ext_vector_type(2)));
typedef float f32x4 __attribute__((ext_vector_type(4)));
typedef GAS unsigned gu32;
#define RLX_AGENT __ATOMIC_RELAXED, __HIP_MEMORY_SCOPE_AGENT
#define LDS_WAIT() asm volatile("s_waitcnt lgkmcnt(0)" ::: "memory")
#define VM_WAIT() asm volatile("s_waitcnt vmcnt(0)" ::: "memory")
__device__ __forceinline__ unsigned f2bf(float f) { unsigned u = __builtin_bit_cast(unsigned, f); return (u + 0x7fffu + ((u >> 16) & 1u)) >> 16; }
typedef float mk_f32x2 __attribute__((ext_vector_type(2))); typedef __bf16 mk_bf16x2 __attribute__((ext_vector_type(2)));
__device__ __forceinline__ unsigned pk2(float lo, float hi) { mk_f32x2 v = {lo, hi}; return __builtin_bit_cast(unsigned, __builtin_convertvector(v, mk_bf16x2)); }
__device__ __forceinline__ unsigned pk4_fp8(float a, float b, float c, float d) { int w = __builtin_amdgcn_cvt_pk_fp8_f32(a, b, 0, false); return (unsigned)__builtin_amdgcn_cvt_pk_fp8_f32(c, d, w, true); }
__device__ __forceinline__ float bflo(unsigned w) { return __uint_as_float(w << 16); }
__device__ __forceinline__ float bfhi(unsigned w) { return __uint_as_float(w & 0xffff0000u); }
__device__ __forceinline__ float bf2f(bf16 h) { return __uint_as_float((unsigned)h << 16); }
__device__ __forceinline__ float sigm(float x) { return __builtin_amdgcn_rcpf(1.0f + __builtin_amdgcn_exp2f(-LOG2E * x)); }
__device__ __forceinline__ float wave_sum(float v) {
#pragma unroll
    for (int o = 1; o < 64; o <<= 1) v += __shfl_xor(v, o);
    return v;
}
__device__ __forceinline__ float wave_max(float v) {
#pragma unroll
    for (int o = 1; o < 64; o <<= 1) v = fmaxf(v, __shfl_xor(v, o));
    return v;
}
__device__ __forceinline__ unsigned ld_ctl(const gu32* p) { return (unsigned)__builtin_amdgcn_readfirstlane((int)__hip_atomic_load(p, RLX_AGENT)); }

namespace mk {
using pg8::Unit; using pg8::BM; using pg8::HALF; using pg8::u32x4; using pg8::cvt_pk_bf16;
struct EpiInProj {
    static constexpr bool PERM = true, AFTER_DRAIN = false;
    bf16* qkvu; bf16* gates; const float* rstd;
    __device__ __forceinline__ void operator()(const f32x4 (&acc)[2][2][4][2], const Unit& u, int wr, int wc, int fr, int fq) const {
        const int row0 = u.pm * BM + wr * 64 + fr; const bool isg = u.pn >= 8;
        bf16* base = isg ? gates : qkvu; const int col0 = (u.pn & 7) * BM + wc * 32 + 8 * fq; const float qs = (u.pn < 2) ? 0.125f * LOG2E : 1.0f;
#pragma unroll
        for (int ai = 0; ai < 2; ++ai)
#pragma unroll
            for (int m = 0; m < 4; ++m) { const int row = row0 + ai * HALF + m * 16; const float rs = rstd[row] * qs; bf16* rowp = base + (size_t)row * QP + col0;
#pragma unroll
                for (int bj = 0; bj < 2; ++bj) { f32x4 v0 = acc[ai][bj][m][0] * rs, v1 = acc[ai][bj][m][1] * rs;
                    if (isg) { v0 = (f32x4){sigm(v0[0]), sigm(v0[1]), sigm(v0[2]), sigm(v0[3])}; v1 = (f32x4){sigm(v1[0]), sigm(v1[1]), sigm(v1[2]), sigm(v1[3])}; }
                    u32x4 w; w.x = cvt_pk_bf16(v0[0], v0[1]); w.y = cvt_pk_bf16(v0[2], v0[3]); w.z = cvt_pk_bf16(v1[0], v1[1]); w.w = cvt_pk_bf16(v1[2], v1[3]);
                    *(u32x4*)(rowp + bj * HALF) = w; } }
    }
};
template <bool ADD> struct EpiGateMul {
    static constexpr bool PERM = true, AFTER_DRAIN = false;
    const bf16* gates; int goff; const bf16* add; bf16* out;
    __device__ __forceinline__ void operator()(const f32x4 (&acc)[2][2][4][2], const Unit& u, int wr, int wc, int fr, int fq) const {
        const int row0 = u.pm * BM + wr * 64 + fr; const int col0 = u.pn * BM + wc * 32 + 8 * fq;
#pragma unroll
        for (int ai = 0; ai < 2; ++ai)
#pragma unroll
            for (int m = 0; m < 4; ++m) { const int row = row0 + ai * HALF + m * 16;
#pragma unroll
                for (int bj = 0; bj < 2; ++bj) { const int c = col0 + bj * HALF;
                    const u32x4 g = *(const u32x4*)(gates + (size_t)row * QP + goff + c);
                    f32x4 v0 = acc[ai][bj][m][0] * (f32x4){bflo(g.x), bfhi(g.x), bflo(g.y), bfhi(g.y)}, v1 = acc[ai][bj][m][1] * (f32x4){bflo(g.z), bfhi(g.z), bflo(g.w), bfhi(g.w)};
                    if (ADD) { const u32x4 a = *(const u32x4*)(add + (size_t)row * D + c); v0 += (f32x4){bflo(a.x), bfhi(a.x), bflo(a.y), bfhi(a.y)}; v1 += (f32x4){bflo(a.z), bfhi(a.z), bflo(a.w), bfhi(a.w)}; }
                    u32x4 w; w.x = cvt_pk_bf16(v0[0], v0[1]); w.y = cvt_pk_bf16(v0[2], v0[3]); w.z = cvt_pk_bf16(v1[0], v1[1]); w.w = cvt_pk_bf16(v1[2], v1[3]);
                    *(u32x4*)(out + (size_t)row * D + c) = w; } }
    }
};
struct EpiResF32 {
    static constexpr bool PERM = false, AFTER_DRAIN = false;
    const float* base; float* out;
    __device__ __forceinline__ void operator()(const f32x4 (&acc)[2][2][4][2], const Unit& u, int wr, int wc, int fr, int fq) const {
        const int row0 = u.pm * BM + wr * 64 + fr; const int col0 = u.pn * BM + wc * 32 + 4 * fq;
#pragma unroll
        for (int ai = 0; ai < 2; ++ai)
#pragma unroll
            for (int m = 0; m < 4; ++m) { const size_t off = (size_t)(row0 + ai * HALF + m * 16) * D + col0;
#pragma unroll
                for (int bj = 0; bj < 2; ++bj)
#pragma unroll
                    for (int n = 0; n < 2; ++n) { const f32x4 b = *(const f32x4*)(base + off + bj * HALF + n * 16); *(f32x4*)(out + off + bj * HALF + n * 16) = b + acc[ai][bj][m][n]; } }
    }
};
__device__ __forceinline__ float glu1(float g, float l) { g = fminf(g, 7.0f); l = fminf(fmaxf(l, -7.0f), 7.0f); return (l + 1.0f) * g * __builtin_amdgcn_rcpf(1.0f + __builtin_amdgcn_exp2f(-1.702f * LOG2E * g)); }
struct EpiGlu {
    static constexpr bool PERM = true, AFTER_DRAIN = false;
    const float* bgu; unsigned char* H;
    __device__ __forceinline__ void operator()(const f32x4 (&acc)[2][2][4][2], const Unit& u, int wr, int wc, int fr, int fq) const {
        const int e = u.pn >> 3, pnl = u.pn & 7; const int row0 = u.pm * BM + wr * 64 + fr; const int col0 = pnl * BM + wc * 32 + 8 * fq;
        f32x4 bv[2][2];
#pragma unroll
        for (int bj = 0; bj < 2; ++bj)
#pragma unroll
            for (int n = 0; n < 2; ++n) bv[bj][n] = *(const f32x4*)(bgu + (size_t)e * 2048 + col0 + bj * HALF + 4 * n);
#pragma unroll
        for (int ai = 0; ai < 2; ++ai)
#pragma unroll
            for (int m = 0; m < 4; ++m) { const int row = row0 + ai * HALF + m * 16;
#pragma unroll
                for (int bj = 0; bj < 2; ++bj) { const f32x4 v0 = acc[ai][bj][m][0] * W8_INV + bv[bj][0], v1 = acc[ai][bj][m][1] * W8_INV + bv[bj][1];
                    *(unsigned*)(H + (size_t)row * FF + ((col0 + bj * HALF) >> 1)) = pk4_fp8(glu1(v0[0], v0[1]), glu1(v0[2], v0[3]), glu1(v1[0], v1[1]), glu1(v1[2], v1[3])); } }
    }
};
struct EpiDown {
    static constexpr bool PERM = true, AFTER_DRAIN = false;
    const float* bd; const float* roww; bf16* Y;
    __device__ __forceinline__ void operator()(const f32x4 (&acc)[2][2][4][2], const Unit& u, int wr, int wc, int fr, int fq) const {
        const int e = u.pn >> 2, pnl = u.pn & 3; const int row0 = u.pm * BM + wr * 64 + fr; const int col0 = pnl * BM + wc * 32 + 8 * fq;
        f32x4 bv[2][2];
#pragma unroll
        for (int bj = 0; bj < 2; ++bj)
#pragma unroll
            for (int n = 0; n < 2; ++n) bv[bj][n] = *(const f32x4*)(bd + (size_t)e * D + col0 + bj * HALF + 4 * n);
#pragma unroll
        for (int ai = 0; ai < 2; ++ai)
#pragma unroll
            for (int m = 0; m < 4; ++m) { const int row = row0 + ai * HALF + m * 16; const float rw = roww[row];
#pragma unroll
                for (int bj = 0; bj < 2; ++bj) { const f32x4 v0 = (acc[ai][bj][m][0] * W8_INV + bv[bj][0]) * rw, v1 = (acc[ai][bj][m][1] * W8_INV + bv[bj][1]) * rw;
                    u32x4 w; w.x = cvt_pk_bf16(v0[0], v0[1]); w.y = cvt_pk_bf16(v0[2], v0[3]); w.z = cvt_pk_bf16(v1[0], v1[1]); w.w = cvt_pk_bf16(v1[2], v1[3]);
                    *(u32x4*)(Y + (size_t)row * D + col0 + bj * HALF) = w; } }
    }
};
struct EpiBf {
    static constexpr bool PERM = true, AFTER_DRAIN = false;
    bf16* out;
    __device__ __forceinline__ void operator()(const f32x4 (&acc)[2][2][4][2], const Unit& u, int wr, int wc, int fr, int fq) const {
        const int row0 = u.pm * BM + wr * 64 + fr; const int col0 = u.pn * BM + wc * 32 + 8 * fq;
#pragma unroll
        for (int ai = 0; ai < 2; ++ai)
#pragma unroll
            for (int m = 0; m < 4; ++m) { bf16* rowp = out + (size_t)(row0 + ai * HALF + m * 16) * D + col0;
#pragma unroll
                for (int bj = 0; bj < 2; ++bj) { const f32x4 v0 = acc[ai][bj][m][0], v1 = acc[ai][bj][m][1];
                    u32x4 w; w.x = cvt_pk_bf16(v0[0], v0[1]); w.y = cvt_pk_bf16(v0[2], v0[3]); w.z = cvt_pk_bf16(v1[0], v1[1]); w.w = cvt_pk_bf16(v1[2], v1[3]);
                    *(u32x4*)(rowp + bj * HALF) = w; } }
    }
};
struct EpiPle {
    static constexpr bool PERM = false, AFTER_DRAIN = false;
    float* xio; const bf16* prj;
    __device__ __forceinline__ void operator()(const f32x4 (&acc)[2][2][4][2], const Unit& u, int wr, int wc, int fr, int fq) const {
        const int row0 = u.pm * BM + wr * 64 + fr; const int col0 = u.pn * BM + wc * 32 + 4 * fq;
#pragma unroll
        for (int ai = 0; ai < 2; ++ai)
#pragma unroll
            for (int m = 0; m < 4; ++m) { const size_t off = (size_t)(row0 + ai * HALF + m * 16) * D + col0;
#pragma unroll
                for (int bj = 0; bj < 2; ++bj)
#pragma unroll
                    for (int n = 0; n < 2; ++n) { const size_t c = off + bj * HALF + n * 16; const f32x4 xv = *(const f32x4*)(xio + c); const v2u p = *(const v2u*)(prj + c); const f32x4 a = acc[ai][bj][m][n];
                        *(f32x4*)(xio + c) = xv + (f32x4){sigm(a[0]) * bflo(p.x), sigm(a[1]) * bfhi(p.x), sigm(a[2]) * bflo(p.y), sigm(a[3]) * bfhi(p.y)}; } }
    }
};
struct MoeOrder {
    const gu32* tiles; int TM, NT, G, c;
    __device__ __forceinline__ void init(const gu32* t, int nt, int G_, int c_) { tiles = t; NT = nt; G = G_; c = c_; TM = (int)ld_ctl(t); }
    __device__ __forceinline__ bool next(int i, Unit& u) const {
        const long L = (long)i * G + c; if (L >= (long)TM * NT) return false;
        const int mt = (int)(L / NT), pn = (int)(L % NT);
        u.pm = (int)ld_ctl(tiles + 64 + 2 * mt); u.pn = (int)ld_ctl(tiles + 64 + 2 * mt + 1) * NT + pn; return true;
    }
    __device__ __forceinline__ void a_ready(const Unit&) const {}
    __device__ __forceinline__ void done(const Unit&) const {}
};
}

__device__ __forceinline__ void tr_item(const float* W, int K, int N, const float* ks, bf16* WT, int item, int lane) {
    const int nblk = N / 32, kb = item / nblk, nb = item % nblk, nc = lane >> 3, kr = lane & 7;
    const float* src = W + (size_t)(64 * kb + 8 * kr) * N + 32 * nb + 4 * nc;
    f32x4 v[8];
#pragma unroll
    for (int i = 0; i < 8; ++i) v[i] = *(const f32x4*)(src + (size_t)i * N);
    if (ks) { const f32x4 a = *(const f32x4*)(ks + 64 * kb + 8 * kr), b = *(const f32x4*)(ks + 64 * kb + 8 * kr + 4);
        v[0] *= a.x; v[1] *= a.y; v[2] *= a.z; v[3] *= a.w; v[4] *= b.x; v[5] *= b.y; v[6] *= b.z; v[7] *= b.w; }
    bf16* dst = WT + (size_t)(32 * nb + 4 * nc) * K + 64 * kb + 8 * kr;
#pragma unroll
    for (int e = 0; e < 4; ++e) { v4u o; o.x = pk2(v[0][e], v[1][e]); o.y = pk2(v[2][e], v[3][e]); o.z = pk2(v[4][e], v[5][e]); o.w = pk2(v[6][e], v[7][e]);
        *(GAS v4u*)(dst + (size_t)e * K) = o; }
}

__device__ __forceinline__ void tr_item_f8(const float* W, int K, int N, const float* ks, unsigned char* WT, int item, int lane) {
    const int nblk = N / 32, kb = item / nblk, nb = item % nblk, nc = lane >> 3, kr = lane & 7;
    const float* src = W + (size_t)(128 * kb + 16 * kr) * N + 32 * nb + 4 * nc;
    f32x4 v[16];
#pragma unroll
    for (int i = 0; i < 16; ++i) v[i] = *(const f32x4*)(src + (size_t)i * N);
#pragma unroll
    for (int q = 0; q < 4; ++q) { f32x4 a = {W8_SCALE, W8_SCALE, W8_SCALE, W8_SCALE}; if (ks) a = *(const f32x4*)(ks + 128 * kb + 16 * kr + 4 * q) * W8_SCALE;
        v[4 * q] *= a.x; v[4 * q + 1] *= a.y; v[4 * q + 2] *= a.z; v[4 * q + 3] *= a.w; }
    unsigned char* dst = WT + (size_t)(32 * nb + 4 * nc) * K + 128 * kb + 16 * kr;
#pragma unroll
    for (int e = 0; e < 4; ++e) { v4u o; o.x = pk4_fp8(v[0][e], v[1][e], v[2][e], v[3][e]); o.y = pk4_fp8(v[4][e], v[5][e], v[6][e], v[7][e]); o.z = pk4_fp8(v[8][e], v[9][e], v[10][e], v[11][e]); o.w = pk4_fp8(v[12][e], v[13][e], v[14][e], v[15][e]);
        *(GAS v4u*)(dst + (size_t)e * K) = o; }
}

struct Ptrs {
    const float *x, *p, *relb, *g_mix, *w_in, *pool_w, *pool_scale, *w_oa, *w_op, *w_out, *g_ffn, *rw, *rb, *w_gu, *b_gu, *w_d, *b_d, *g_ple, *w_pg, *w_pp, *g_fin;
    float* out; unsigned char* ws; gu32* ctl;
    bf16 *WinT, *WaT, *WcT, *WoutT, *WpgT, *WppT, *WguT, *WdT, *XB, *PB, *QKVU, *GATES, *PIN, *ATT, *TMP, *MERGED, *X1N, *XG, *H, *Y, *X2N, *PRJ, *KF, *VF, *ATT2;
    float *RSTD0, *KMEAN, *TOPW, *ROWW; int *TOPI, *INV;
    unsigned char *Wgu8, *Wd8, *X1N8, *XG8, *H8;
};

__device__ __forceinline__ void p0_prologue(const Ptrs& P, LAS unsigned char* lds, int gw, int NGW, int wave, int lane) {
    constexpr int I_IN = 16 * 128, I_OA = 8 * 32, I_OUT = 16 * 32, I_PG = 16 * 32, I_PP = 4 * 32, I_GU1 = 8 * 64, I_D1 = 8 * 32;
    constexpr int I_GU = NE * I_GU1, I_D = NE * I_D1, NITEMS = I_IN + I_OA + I_OUT + I_PG + I_PP + I_GU + I_D;
    for (int it = gw; it < NITEMS; it += NGW) {
        int r = it;
        if (r < I_GU) { const int e = r / I_GU1; tr_item_f8(P.w_gu + (size_t)e * D * 2048, D, 2048, P.g_ffn, P.Wgu8 + (size_t)e * 2048 * D, r % I_GU1, lane); continue; } r -= I_GU;
        if (r < I_D) { const int e = r / I_D1; tr_item_f8(P.w_d + (size_t)e * FF * D, FF, D, nullptr, P.Wd8 + (size_t)e * D * FF, r % I_D1, lane); continue; } r -= I_D;
        if (r < I_IN) { tr_item(P.w_in, D, INC, P.g_mix, P.WinT, r, lane); continue; } r -= I_IN;
        if (r < I_OA) { tr_item(P.w_oa, AW, D, nullptr, P.WaT, r, lane); continue; } r -= I_OA;
        if (r < I_OUT) { tr_item(P.w_out, D, D, nullptr, P.WoutT, r, lane); continue; } r -= I_OUT;
        if (r < I_PG) { tr_item(P.w_pg, D, D, P.g_ple, P.WpgT, r, lane); continue; } r -= I_PG;
        tr_item(P.w_pp, PLE, D, nullptr, P.WppT, r, lane);
    }
    for (int it = gw; it < 512 * 4; it += NGW) {
        const int k = it >> 2, n0 = (it & 3) * 256 + lane * 4, g = k >> 7;
        f32x4 a = {0.f, 0.f, 0.f, 0.f};
#pragma unroll 16
        for (int j = 0; j < 128; ++j) { const float s = P.pool_w[(size_t)k * 128 + j] * P.pool_scale[g * 128 + j]; const f32x4 w = *(const f32x4*)(P.w_op + (size_t)(g * 128 + j) * D + n0); a += w * s; }
#pragma unroll
        for (int i = 0; i < 4; ++i) P.WcT[(size_t)(n0 + i) * PW + k] = (bf16)f2bf(a[i]);
    }
    for (int m = gw; m < M; m += NGW) {
        const GAS f32x4* xr = (const GAS f32x4*)(P.x + (size_t)m * D) + lane; f32x4 v[4]; float s = 0.f;
#pragma unroll
        for (int j = 0; j < 4; ++j) { v[j] = xr[64 * j]; s += (v[j].x * v[j].x + v[j].y * v[j].y) + (v[j].z * v[j].z + v[j].w * v[j].w); }
        s = wave_sum(s); if (lane == 0) P.RSTD0[m] = 1.0f / sqrtf(s * (1.0f / D) + RMS_EPS);
        GAS unsigned long long* o8 = (GAS unsigned long long*)(P.XB + (size_t)m * D) + lane;
#pragma unroll
        for (int j = 0; j < 4; ++j) o8[64 * j] = (unsigned long long)pk2(v[j].x, v[j].y) | ((unsigned long long)pk2(v[j].z, v[j].w) << 32);
    }
    for (int i = gw * 64 + lane; i < M * PLE / 8; i += NGW * 64) { const f32x4 a = ((const f32x4*)P.p)[2 * i], b = ((const f32x4*)P.p)[2 * i + 1];
        v4u o; o.x = pk2(a.x, a.y); o.y = pk2(a.z, a.w); o.z = pk2(b.x, b.y); o.w = pk2(b.z, b.w); ((v4u*)P.PB)[i] = o; }
}

__device__ __forceinline__ void p2_kmean_pin(const Ptrs& P, int gw, int NGW, int lane) {
    for (int it = gw; it < BATCH * NH * (SEQ / 32); it += NGW) {
        const int G32 = it & 255, h = (it >> 8) & 7, b = it >> 11; const int c = lane & 31, hi = lane >> 5;
        const int kap = (c & 0x13) | ((c & 4) << 1) | ((c & 8) >> 1);
        const bf16* kr = P.QKVU + (size_t)(b * SEQ + 32 * G32 + kap) * QP + AW + h * HD + 8 * hi;
        v4u kv[4];
#pragma unroll
        for (int d0 = 0; d0 < 4; ++d0) kv[d0] = *(const v4u*)(kr + 16 * d0);
        const bf16* vr = P.QKVU + (size_t)(b * SEQ + 32 * G32 + 8 * hi) * QP + 2 * AW + h * HD + c;
        unsigned short vv[2][2][8];
#pragma unroll
        for (int s = 0; s < 2; ++s)
#pragma unroll
            for (int db = 0; db < 2; ++db)
#pragma unroll
                for (int i = 0; i < 8; ++i) vv[s][db][i] = vr[(size_t)(16 * s + i) * QP + 32 * db];
        v4u* kd = (v4u*)P.KF + ((size_t)((b * NH + h) * 256 + G32) * 4) * 64 + lane;
#pragma unroll
        for (int d0 = 0; d0 < 4; ++d0) kd[d0 * 64] = kv[d0];
        v4u* vd = (v4u*)P.VF + ((size_t)((b * NH + h) * 256 + G32) * 4) * 64 + lane;
#pragma unroll
        for (int s = 0; s < 2; ++s)
#pragma unroll
            for (int db = 0; db < 2; ++db) { v4u o; o.x = vv[s][db][0] | ((unsigned)vv[s][db][1] << 16); o.y = vv[s][db][2] | ((unsigned)vv[s][db][3] << 16); o.z = vv[s][db][4] | ((unsigned)vv[s][db][5] << 16); o.w = vv[s][db][6] | ((unsigned)vv[s][db][7] << 16);
                vd[(s * 2 + db) * 64] = o; }
    }
    for (int it = gw; it < BATCH * NBLK * NH; it += NGW) {
        const int h = it & 7, n = (it >> 3) & 31, b = it >> 8;
        const bf16* kp = P.QKVU + (size_t)(b * SEQ + n * MOBA) * QP + AW + h * HD + lane; float s = 0.f;
#pragma unroll 8
        for (int i = 0; i < MOBA; ++i) s += bf2f(kp[(size_t)i * QP]);
        P.KMEAN[((size_t)(b * NH + h) * NBLK + n) * HD + lane] = s * (1.0f / MOBA);
    }
    for (int r = gw; r < M; r += NGW) {
        const int s = r & (SEQ - 1), g = lane >> 4, w = 2 << g; const int cnt = (s + 1 < w) ? s + 1 : w;
        const bf16* up = P.QKVU + (size_t)r * QP + 3 * AW + lane * 8; float a[8];
#pragma unroll
        for (int i = 0; i < 8; ++i) a[i] = 0.f;
        for (int i = 0; i < 16; ++i) if (i < cnt) { const v4u q = *(const v4u*)(up - (size_t)i * QP);
            a[0] += bflo(q.x); a[1] += bfhi(q.x); a[2] += bflo(q.y); a[3] += bfhi(q.y); a[4] += bflo(q.z); a[5] += bfhi(q.z); a[6] += bflo(q.w); a[7] += bfhi(q.w); }
        const v4u q = *(const v4u*)up; const float ic = 1.0f / (float)cnt;
        v4u o; o.x = pk2(a[0] * ic - bflo(q.x), a[1] * ic - bfhi(q.x)); o.y = pk2(a[2] * ic - bflo(q.y), a[3] * ic - bfhi(q.y));
        o.z = pk2(a[4] * ic - bflo(q.z), a[5] * ic - bfhi(q.z)); o.w = pk2(a[6] * ic - bflo(q.w), a[7] * ic - bfhi(q.w));
        *(v4u*)(P.PIN + (size_t)r * PW + lane * 8) = o;
    }
}

__device__ __forceinline__ int t5_bucket(int rel) {
    const int n = rel < 0 ? 0 : rel; if (n < 16) return n;
    int b = 16; b += (n >= 19); b += (n >= 21); b += (n >= 24); b += (n >= 27); b += (n >= 31); b += (n >= 35); b += (n >= 40); b += (n >= 46);
    b += (n >= 52); b += (n >= 59); b += (n >= 67); b += (n >= 77); b += (n >= 87); b += (n >= 99); b += (n >= 113); return b;
}

__device__ __forceinline__ void p3_attn_simple(const Ptrs& P, bf16* dst, int gw, int NGW, int lane) {
    const float NEG = -INFINITY;
    for (int idx = gw; idx < M * NH; idx += NGW) {
        const int t = idx >> 3, h = idx & 7, b = t >> 13, s = t & (SEQ - 1), j = s >> 8;
        const float qv = bf2f(P.QKVU[(size_t)t * QP + h * HD + lane]);
        float qs[64];
#pragma unroll
        for (int d = 0; d < 64; ++d) qs[d] = __builtin_bit_cast(float, __builtin_amdgcn_readlane(__builtin_bit_cast(int, qv), d));
        float g = NEG;
        if (lane < j) { const float* km = P.KMEAN + ((size_t)(b * NH + h) * NBLK + lane) * HD; float a = 0.f;
#pragma unroll
            for (int d = 0; d < 64; ++d) a += qs[d] * km[d];
            g = a; }
        int sel[3];
#pragma unroll
        for (int r = 0; r < 3; ++r) { const float mx = wave_max(g); const unsigned long long bal = __ballot(g == mx); const int ix = __ffsll((long long)bal) - 1; sel[r] = ix; if (lane == ix) g = NEG; }
        const int nvalid = j < 3 ? j : 3;
        float m = NEG, l = 0.f, o = 0.f;
        for (int pc = 0; pc <= nvalid; ++pc) {
            const int n = (pc == 0) ? j : (pc == 1 ? sel[0] : (pc == 2 ? sel[1] : sel[2]));
            const int nch = (pc == 0) ? (((s & 255) >> 6) + 1) : 4;
            for (int c = 0; c < nch; ++c) {
                const int key = n * MOBA + c * 64 + lane, rel = s - key;
                const v4u* kr = (const v4u*)(P.QKVU + (size_t)(b * SEQ + key) * QP + AW + h * HD);
                float sc = 0.f;
#pragma unroll
                for (int i = 0; i < 8; ++i) { const v4u w = kr[i];
                    sc += qs[8 * i] * bflo(w.x) + qs[8 * i + 1] * bfhi(w.x) + qs[8 * i + 2] * bflo(w.y) + qs[8 * i + 3] * bfhi(w.y) + qs[8 * i + 4] * bflo(w.z) + qs[8 * i + 5] * bfhi(w.z) + qs[8 * i + 6] * bflo(w.w) + qs[8 * i + 7] * bfhi(w.w); }
                sc += P.relb[t5_bucket(rel) * NH + h] * LOG2E; if (rel < 0) sc = NEG;
                const float cm = wave_max(sc), mn = fmaxf(m, cm);
                const float pr = __builtin_amdgcn_exp2f(sc - mn), al = __builtin_amdgcn_exp2f(m - mn);
                l = l * al + wave_sum(pr); o *= al; m = mn;
                const bf16* vb = P.QKVU + (size_t)(b * SEQ + n * MOBA + c * 64) * QP + 2 * AW + h * HD + lane;
#pragma unroll 16
                for (int kk = 0; kk < 64; ++kk) o += __builtin_bit_cast(float, __builtin_amdgcn_readlane(__builtin_bit_cast(int, pr), kk)) * bf2f(vb[(size_t)kk * QP]);
            }
        }
        dst[(size_t)t * AW + h * HD + lane] = (bf16)f2bf(o / l);
    }
}

__device__ __forceinline__ void p6_router(const Ptrs& P, LAS unsigned char* lds, int G, int tid, int wave, int lane) {
    LAS float* XS = (LAS float*)lds;
    LAS float* PART = (LAS float*)(lds + 65536);
    LAS float* LG = (LAS float*)(lds + 98304);
    LAS float* RS = (LAS float*)(lds + 100352);
    LAS unsigned* HIST = (LAS unsigned*)(lds + 100480);
    const int e = lane & 31, kq = lane >> 5, kbase = 128 * wave + 64 * kq;
    float wreg[64];
#pragma unroll
    for (int i = 0; i < 64; ++i) wreg[i] = P.rw[(size_t)(kbase + i) * NE + e] * P.g_ffn[kbase + i];
    for (int chunk = blockIdx.x; chunk < M / 64; chunk += G) {
        if (tid < 32) HIST[tid] = 0u;
        for (int bt = 0; bt < 4; ++bt) {
            __syncthreads();
#pragma unroll
            for (int tt = 0; tt < 2; ++tt) { const int tl = wave * 2 + tt, row = chunk * 64 + bt * 16 + tl;
                const GAS f32x4* xr = (const GAS f32x4*)(P.out + (size_t)row * D) + lane; f32x4 v[4]; float s = 0.f;
#pragma unroll
                for (int j = 0; j < 4; ++j) { v[j] = xr[64 * j]; s += (v[j].x * v[j].x + v[j].y * v[j].y) + (v[j].z * v[j].z + v[j].w * v[j].w); }
                s = wave_sum(s); const float rs = 1.0f / sqrtf(s * (1.0f / D) + RMS_EPS);
                GAS unsigned* o4 = (GAS unsigned*)(P.X1N8 + (size_t)row * D) + lane;
#pragma unroll
                for (int j = 0; j < 4; ++j) { *(LAS f32x4*)(XS + tl * 1024 + 4 * lane + 256 * j) = v[j];
                    o4[64 * j] = pk4_fp8(v[j].x * rs, v[j].y * rs, v[j].z * rs, v[j].w * rs); }
                if (lane == 0) RS[tl] = rs; }
            __syncthreads();
            for (int tl = 0; tl < 16; ++tl) { float a = 0.f;
#pragma unroll
                for (int i4 = 0; i4 < 16; ++i4) { const f32x4 xv = *(const LAS f32x4*)(XS + tl * 1024 + kbase + 4 * i4);
                    a += xv.x * wreg[4 * i4] + xv.y * wreg[4 * i4 + 1] + xv.z * wreg[4 * i4 + 2] + xv.w * wreg[4 * i4 + 3]; }
                PART[(tl * 16 + wave * 2 + kq) * 32 + e] = a; }
            __syncthreads();
            { const int tl = tid >> 5, ee = tid & 31; float a = 0.f;
#pragma unroll
                for (int q = 0; q < 16; ++q) a += PART[(tl * 16 + q) * 32 + ee];
                LG[tl * 32 + ee] = a * RS[tl] + P.rb[ee]; }
            __syncthreads();
            { const int tl = wave * 2 + kq, row = chunk * 64 + bt * 16 + tl; float v = LG[tl * 32 + e]; float tv[4]; int ti[4];
#pragma unroll
                for (int r = 0; r < 4; ++r) { float mx = v;
#pragma unroll
                    for (int o = 1; o < 32; o <<= 1) mx = fmaxf(mx, __shfl_xor(mx, o));
                    const unsigned long long bal = __ballot(v == mx); const unsigned hm = kq ? (unsigned)(bal >> 32) : (unsigned)bal; const int ix = __ffs((int)hm) - 1;
                    tv[r] = mx; ti[r] = ix; if (e == ix) v = -INFINITY; }
                const float e1 = __builtin_amdgcn_exp2f((tv[1] - tv[0]) * LOG2E), e2 = __builtin_amdgcn_exp2f((tv[2] - tv[0]) * LOG2E), e3 = __builtin_amdgcn_exp2f((tv[3] - tv[0]) * LOG2E);
                const float inv = 1.0f / (1.0f + e1 + e2 + e3);
                if (e == 0) { P.TOPI[row * 4 + 0] = ti[0]; P.TOPI[row * 4 + 1] = ti[1]; P.TOPI[row * 4 + 2] = ti[2]; P.TOPI[row * 4 + 3] = ti[3];
                    P.TOPW[row * 4 + 0] = inv; P.TOPW[row * 4 + 1] = e1 * inv; P.TOPW[row * 4 + 2] = e2 * inv; P.TOPW[row * 4 + 3] = e3 * inv;
                    __hip_atomic_fetch_add(HIST + ti[0], 1u, __ATOMIC_RELAXED, __HIP_MEMORY_SCOPE_WORKGROUP); __hip_atomic_fetch_add(HIST + ti[1], 1u, __ATOMIC_RELAXED, __HIP_MEMORY_SCOPE_WORKGROUP); __hip_atomic_fetch_add(HIST + ti[2], 1u, __ATOMIC_RELAXED, __HIP_MEMORY_SCOPE_WORKGROUP); __hip_atomic_fetch_add(HIST + ti[3], 1u, __ATOMIC_RELAXED, __HIP_MEMORY_SCOPE_WORKGROUP); } }
        }
        __syncthreads();
        if (tid < 32) P.ctl[CW_CNT + chunk * 32 + tid] = HIST[tid];
        __syncthreads();
    }
}

__device__ __forceinline__ void p7_permute(const Ptrs& P, LAS unsigned char* lds, int G, int tid, int wave, int lane) {
    LAS unsigned* SUMT = (LAS unsigned*)lds;
    LAS unsigned* SUMB = SUMT + 512;
    LAS unsigned* TOT = SUMB + 512;
    LAS unsigned* BASEP = TOT + 32; LAS unsigned* NTM = BASEP + 32; LAS unsigned* PST = NTM + 32;
    LAS unsigned* ES = PST + 32;
    LAS unsigned* POS = ES + 256;
    for (int chunk = blockIdx.x; chunk < M / 64; chunk += G) {
        { const int e = tid & 31, part = tid >> 5; unsigned st = 0u, sb = 0u;
            for (int c = 16 * part; c < 16 * part + 16; ++c) { const unsigned v = __hip_atomic_load(P.ctl + CW_CNT + c * 32 + e, RLX_AGENT); st += v; if (c < chunk) sb += v; }
            SUMT[part * 32 + e] = st; SUMB[part * 32 + e] = sb; }
        __syncthreads();
        if (tid < 32) { unsigned st = 0u, sb = 0u;
            for (int q = 0; q < 16; ++q) { st += SUMT[q * 32 + tid]; sb += SUMB[q * 32 + tid]; }
            TOT[tid] = st; BASEP[tid] = sb; NTM[tid] = (st + 255u) >> 8; }
        __syncthreads();
        if (tid < 32) { unsigned ps = 0u; for (int q = 0; q < tid; ++q) ps += NTM[q]; PST[tid] = ps * 256u; }
        if (tid < 256) ES[tid] = (unsigned)P.TOPI[(chunk * 64 + (tid >> 2)) * 4 + (tid & 3)];
        __syncthreads();
        if (tid < 256) { const unsigned e = ES[tid]; unsigned rank = 0u;
            for (int a = 0; a < tid; ++a) rank += (ES[a] == e) ? 1u : 0u;
            const unsigned pos = PST[e] + BASEP[e] + rank; const int ta = (chunk * 64 + (tid >> 2)) * 4 + (tid & 3);
            P.INV[ta] = (int)pos; P.ROWW[pos] = P.TOPW[ta]; POS[tid] = pos; }
        __syncthreads();
        for (int a = wave * 32; a < wave * 32 + 32; ++a) { const int tok = chunk * 64 + (a >> 2); const unsigned pos = POS[a];
            const v4u* src = (const v4u*)(P.X1N8 + (size_t)tok * D); v4u* dst = (v4u*)(P.XG8 + (size_t)pos * D);
            dst[lane] = src[lane]; }
        if (chunk < NE) { const unsigned r0 = PST[chunk] + TOT[chunk], r1 = PST[chunk] + NTM[chunk] * 256u;
            for (unsigned r = r0 + wave; r < r1; r += NWAVES) { v4u* dst = (v4u*)(P.XG8 + (size_t)r * D); const v4u z = {0u, 0u, 0u, 0u}; dst[lane] = z; if (lane == 0) P.ROWW[r] = 0.f; } }
        if (chunk == 0) { if (tid < 32) { const unsigned pm0 = PST[tid] >> 8; for (unsigned k = 0; k < NTM[tid]; ++k) { P.ctl[CW_TILES + 64 + 2 * (pm0 + k)] = pm0 + k; P.ctl[CW_TILES + 64 + 2 * (pm0 + k) + 1] = (unsigned)tid; } }
            if (tid == 0) P.ctl[CW_TILES] = (PST[31] >> 8) + NTM[31]; }
        __syncthreads();
    }
}

__device__ __forceinline__ void p10_combine(const Ptrs& P, int gw, int NGW, int lane) {
    for (int m = gw; m < M; m += NGW) {
        GAS f32x4* xr = (GAS f32x4*)(P.out + (size_t)m * D) + lane; f32x4 v[4];
#pragma unroll
        for (int j = 0; j < 4; ++j) v[j] = xr[64 * j];
#pragma unroll
        for (int k = 0; k < 4; ++k) { const int pos = P.INV[m * 4 + k]; const v2u* yr = (const v2u*)(P.Y + (size_t)pos * D) + lane;
#pragma unroll
            for (int j = 0; j < 4; ++j) { const v2u y = yr[64 * j]; v[j] += (f32x4){bflo(y.x), bfhi(y.x), bflo(y.y), bfhi(y.y)}; } }
        float s = 0.f;
#pragma unroll
        for (int j = 0; j < 4; ++j) s += (v[j].x * v[j].x + v[j].y * v[j].y) + (v[j].z * v[j].z + v[j].w * v[j].w);
        s = wave_sum(s); const float rs = 1.0f / sqrtf(s * (1.0f / D) + RMS_EPS);
        GAS unsigned long long* o8 = (GAS unsigned long long*)(P.X2N + (size_t)m * D) + lane;
#pragma unroll
        for (int j = 0; j < 4; ++j) { xr[64 * j] = v[j]; o8[64 * j] = (unsigned long long)pk2(v[j].x * rs, v[j].y * rs) | ((unsigned long long)pk2(v[j].z * rs, v[j].w * rs) << 32); }
    }
}

__device__ __forceinline__ void p12_final(const Ptrs& P, int gw, int NGW, int lane) {
    const GAS f32x4* gr = (const GAS f32x4*)P.g_fin + lane; f32x4 gv[4];
#pragma unroll
    for (int j = 0; j < 4; ++j) gv[j] = gr[64 * j];
    for (int m = gw; m < M; m += NGW) {
        GAS f32x4* xr = (GAS f32x4*)(P.out + (size_t)m * D) + lane; f32x4 v[4]; float s = 0.f;
#pragma unroll
        for (int j = 0; j < 4; ++j) { v[j] = xr[64 * j]; s += (v[j].x * v[j].x + v[j].y * v[j].y) + (v[j].z * v[j].z + v[j].w * v[j].w); }
        s = wave_sum(s); const float rs = 1.0f / sqrtf(s * (1.0f / D) + RMS_EPS);
#pragma unroll
        for (int j = 0; j < 4; ++j) xr[64 * j] = v[j] * rs * gv[j];
    }
}


namespace moba {
typedef short bf16x8 __attribute__((ext_vector_type(8)));
typedef float f32x16 __attribute__((ext_vector_type(16)));
typedef float f32x2_t __attribute__((ext_vector_type(2))); typedef __bf16 bf16x2_t __attribute__((ext_vector_type(2)));
constexpr int SO_ROW = 136;
constexpr int A_SO = 0, A_LSE = 3 * 256 * SO_ROW;
constexpr int A_LUT = A_LSE + 3072;
constexpr int A_PAIR = A_LUT + 3072;
constexpr int A_CNT = A_PAIR + 3072;
constexpr int A_OFF = A_CNT + 128;
constexpr int A_GRP = A_OFF + 128;
constexpr int A_NG = A_GRP + 1024;
constexpr int A_END = A_NG + 16;
static_assert(A_END <= RING_BYTES, "attention LDS");
constexpr float C2 = 0.125f * LOG2E;

__device__ __forceinline__ unsigned cvtpk(float lo, float hi) { f32x2_t v = {lo, hi}; bf16x2_t b = __builtin_convertvector(v, bf16x2_t); return __builtin_bit_cast(unsigned, b); }
__device__ __forceinline__ float xhalf_max(float m) { auto rr = __builtin_amdgcn_permlane32_swap(__float_as_uint(m), __float_as_uint(m), false, false); return fmaxf(__uint_as_float(rr[0]), __uint_as_float(rr[1])); }
__device__ __forceinline__ float xhalf_sum(float m) { auto rr = __builtin_amdgcn_permlane32_swap(__float_as_uint(m), __float_as_uint(m), false, false); return __uint_as_float(rr[0]) + __uint_as_float(rr[1]); }
#define MOBA_MFMA(a, b, c) __builtin_amdgcn_mfma_f32_32x32x16_bf16((a), (b), (c), 0, 0, 0)

struct FState { float m, l; f32x16 o0, o1; };

__device__ __forceinline__ void load_k(bf16x8 (&kf)[2][4], const bf16* kfp) {
#pragma unroll
    for (int hf = 0; hf < 2; ++hf)
#pragma unroll
        for (int d0 = 0; d0 < 4; ++d0) kf[hf][d0] = *(const bf16x8*)(kfp + (size_t)((hf * 4 + d0) * 64) * 8);
}
__device__ __forceinline__ void load_v(bf16x8 (&vf)[2][2][2], const bf16* vfp) {
#pragma unroll
    for (int hf = 0; hf < 2; ++hf)
#pragma unroll
        for (int s = 0; s < 2; ++s)
#pragma unroll
            for (int db = 0; db < 2; ++db) vf[hf][s][db] = *(const bf16x8*)(vfp + (size_t)(((hf * 2 + s) * 2 + db) * 64) * 8);
}
template <bool LUTMODE>
__device__ __forceinline__ void qk_softmax(FState& st, const bf16x8 (&qr)[4], const bf16x8 (&kf)[2][4], bf16x8 (&pb)[2][2], float cb, const LAS float* lut, int lidx) {
    f32x16 p[2];
#pragma unroll
    for (int hf = 0; hf < 2; ++hf) {
#pragma unroll
        for (int r = 0; r < 16; ++r) p[hf][r] = LUTMODE ? 0.f : cb;
#pragma unroll
        for (int d0 = 0; d0 < 4; ++d0) p[hf] = MOBA_MFMA(kf[hf][d0], qr[d0], p[hf]);
    }
    if (LUTMODE) {
#pragma unroll
        for (int hf = 0; hf < 2; ++hf)
#pragma unroll
            for (int r = 0; r < 16; ++r) p[hf][r] += lut[lidx - (hf * 32 + (r & 7) + 16 * (r >> 3))];
    }
    float mx = fmaxf(p[0][0], p[1][0]);
#pragma unroll
    for (int r = 1; r < 16; ++r) mx = fmaxf(mx, fmaxf(p[0][r], p[1][r]));
    mx = xhalf_max(mx);
    const float mn = fmaxf(st.m, mx), al = __builtin_amdgcn_exp2f(st.m - mn);
    float rs = 0.f;
#pragma unroll
    for (int hf = 0; hf < 2; ++hf)
#pragma unroll
        for (int r = 0; r < 16; ++r) { p[hf][r] = __builtin_amdgcn_exp2f(p[hf][r] - mn); rs += p[hf][r]; }
    st.l = st.l * al + rs; st.m = mn;
#pragma unroll
    for (int r = 0; r < 16; ++r) { st.o0[r] *= al; st.o1[r] *= al; }
#pragma unroll
    for (int hf = 0; hf < 2; ++hf)
#pragma unroll
        for (int s = 0; s < 2; ++s) {
            v4u w; w.x = cvtpk(p[hf][8 * s], p[hf][8 * s + 1]); w.y = cvtpk(p[hf][8 * s + 2], p[hf][8 * s + 3]); w.z = cvtpk(p[hf][8 * s + 4], p[hf][8 * s + 5]); w.w = cvtpk(p[hf][8 * s + 6], p[hf][8 * s + 7]);
            pb[hf][s] = __builtin_bit_cast(bf16x8, w); }
}
__device__ __forceinline__ void pv_acc(FState& st, const bf16x8 (&vf)[2][2][2], const bf16x8 (&pb)[2][2]) {
#pragma unroll
    for (int hf = 0; hf < 2; ++hf)
#pragma unroll
        for (int s = 0; s < 2; ++s) { st.o0 = MOBA_MFMA(vf[hf][s][0], pb[hf][s], st.o0); st.o1 = MOBA_MFMA(vf[hf][s][1], pb[hf][s], st.o1); }
}
template <bool LUTMODE>
__device__ __forceinline__ void flash_block(FState& st, const bf16x8 (&qr)[4], const bf16* kfb, const bf16* vfb, int nkt, float cb, const LAS float* lut, int lidx) {
    bf16x8 kf[2][4], vf[2][2][2], pb[2][2];
    load_k(kf, kfb); load_v(vf, vfb);
    for (int kt = 0; kt < nkt; ++kt) {
        qk_softmax<LUTMODE>(st, qr, kf, pb, cb, lut, lidx - 64 * kt);
        if (kt + 1 < nkt) load_k(kf, kfb + (size_t)(kt + 1) * 2 * 4 * 64 * 8);
        pv_acc(st, vf, pb);
        if (kt + 1 < nkt) load_v(vf, vfb + (size_t)(kt + 1) * 2 * 4 * 64 * 8);
    }
}

__device__ __forceinline__ void attn_unit(const Ptrs& P, LAS unsigned char* lds, int b, int h, int j, int tid, int wave, int lane) {
    const int c = lane & 31, hi = lane >> 5;
    LAS float* LSE = (LAS float*)(lds + A_LSE); LAS float* LUT = (LAS float*)(lds + A_LUT); LAS unsigned* PAIR = (LAS unsigned*)(lds + A_PAIR);
    LAS unsigned* CNT = (LAS unsigned*)(lds + A_CNT); LAS unsigned* OFF = (LAS unsigned*)(lds + A_OFF); LAS unsigned* GRP = (LAS unsigned*)(lds + A_GRP); LAS unsigned* NGW_ = (LAS unsigned*)(lds + A_NG);
    const size_t row0 = (size_t)b * SEQ;
    const bf16* Qb = P.QKVU + (row0 + (size_t)j * MOBA) * QP + h * HD;
    const bf16* Kf = P.KF + ((size_t)(b * NH + h) * 256 * 4 * 64 + lane) * 8;
    const bf16* Vf = P.VF + ((size_t)(b * NH + h) * 256 * 4 * 64 + lane) * 8;
    const float NEG = -INFINITY;
    if (tid < 32) CNT[tid] = 0u;
    if (tid == 32) { NGW_[0] = 0u; NGW_[1] = 0u; }
    for (int i = tid; i < 768; i += NWAVES * 64) { const int rel = i - 256; LUT[i] = rel < 0 ? NEG : P.relb[t5_bucket(rel) * NH + h] * LOG2E; }
    __syncthreads();
    const float cb31 = LUT[256 + 200];
    const int nvalid = j < 3 ? j : 3;
    const int q_own = 32 * wave + c;
    bf16x8 qo[4];
#pragma unroll
    for (int d0 = 0; d0 < 4; ++d0) qo[d0] = *(const bf16x8*)(Qb + (size_t)q_own * QP + d0 * 16 + hi * 8);
    int sel0 = 0, sel1 = 0, sel2 = 0; unsigned rk0 = 0, rk1 = 0, rk2 = 0;
    if (j > 0) {
        f32x16 g;
#pragma unroll
        for (int r = 0; r < 16; ++r) g[r] = 0.f;
        const float* km = P.KMEAN + ((size_t)(b * NH + h) * NBLK + c) * HD + hi * 8;
#pragma unroll
        for (int d0 = 0; d0 < 4; ++d0) { const f32x4 a = *(const f32x4*)(km + d0 * 16), bq = *(const f32x4*)(km + d0 * 16 + 4);
            const float v[8] = {a.x, a.y, a.z, a.w, bq.x, bq.y, bq.z, bq.w}; unsigned wh[4], wl[4];
#pragma unroll
            for (int i = 0; i < 4; ++i) { const unsigned h0 = f2bf(v[2 * i]), h1 = f2bf(v[2 * i + 1]); wh[i] = h0 | (h1 << 16);
                wl[i] = f2bf(v[2 * i] - __uint_as_float(h0 << 16)) | (f2bf(v[2 * i + 1] - __uint_as_float(h1 << 16)) << 16); }
            const bf16x8 kh = __builtin_bit_cast(bf16x8, (v4u){wh[0], wh[1], wh[2], wh[3]}), kl = __builtin_bit_cast(bf16x8, (v4u){wl[0], wl[1], wl[2], wl[3]});
            g = MOBA_MFMA(kh, qo[d0], g); g = MOBA_MFMA(kl, qo[d0], g); }
#pragma unroll
        for (int r = 0; r < 16; ++r) { const int n = (r & 3) + 8 * (r >> 2) + 4 * hi; if (n >= j) g[r] = NEG; }
#pragma unroll
        for (int s = 0; s < 3; ++s) {
            float bv = g[0]; int bi = 4 * hi;
#pragma unroll
            for (int r = 1; r < 16; ++r) { const int n = (r & 3) + 8 * (r >> 2) + 4 * hi; if (g[r] > bv) { bv = g[r]; bi = n; } }
            const float pv = __shfl_xor(bv, 32); const int pi = __shfl_xor(bi, 32);
            if (pv > bv || (pv == bv && pi < bi)) { bv = pv; bi = pi; }
#pragma unroll
            for (int r = 0; r < 16; ++r) { const int n = (r & 3) + 8 * (r >> 2) + 4 * hi; if (n == bi) g[r] = NEG; }
            if (s == 0) sel0 = bi; else if (s == 1) sel1 = bi; else sel2 = bi;
        }
        if (hi == 0) {
            if (nvalid > 0) rk0 = __hip_atomic_fetch_add(CNT + sel0, 1u, __ATOMIC_RELAXED, __HIP_MEMORY_SCOPE_WORKGROUP);
            if (nvalid > 1) rk1 = __hip_atomic_fetch_add(CNT + sel1, 1u, __ATOMIC_RELAXED, __HIP_MEMORY_SCOPE_WORKGROUP);
            if (nvalid > 2) rk2 = __hip_atomic_fetch_add(CNT + sel2, 1u, __ATOMIC_RELAXED, __HIP_MEMORY_SCOPE_WORKGROUP);
        }
    }
    __syncthreads();
    if (wave == 0) {
        const unsigned cn = (lane < 32 && lane < j) ? CNT[lane & 31] : 0u; const unsigned ng = (cn + 31u) >> 5;
        unsigned po = cn, pg = ng;
#pragma unroll
        for (int o = 1; o < 32; o <<= 1) { const unsigned a = __shfl_up(po, o), bq = __shfl_up(pg, o); if ((lane & 31) >= o) { po += a; pg += bq; } }
        if (lane < 32) { OFF[lane] = po - cn; const unsigned g0 = pg - ng;
            for (unsigned k = 0; k < ng; ++k) { GRP[(g0 + k) * 4] = (unsigned)lane; GRP[(g0 + k) * 4 + 1] = po - cn + 32u * k; GRP[(g0 + k) * 4 + 2] = (cn - 32u * k) < 32u ? (cn - 32u * k) : 32u; }
            if (lane == 31) NGW_[0] = pg; }
    }
    __syncthreads();
    if (hi == 0 && j > 0) {
        if (nvalid > 0) PAIR[OFF[sel0] + rk0] = (unsigned)q_own;
        if (nvalid > 1) PAIR[OFF[sel1] + rk1] = (unsigned)q_own | (1u << 8);
        if (nvalid > 2) PAIR[OFF[sel2] + rk2] = (unsigned)q_own | (2u << 8);
    }
    __syncthreads();
    const unsigned NG = NGW_[0];
    for (;;) {
        unsigned gi = 0u; if (lane == 0) gi = __hip_atomic_fetch_add(NGW_ + 1, 1u, __ATOMIC_RELAXED, __HIP_MEMORY_SCOPE_WORKGROUP);
        gi = (unsigned)__builtin_amdgcn_readfirstlane((int)gi);
        if (gi >= NG) break;
        const int n = (int)GRP[gi * 4], first = (int)GRP[gi * 4 + 1], cnt = (int)GRP[gi * 4 + 2];
        const unsigned pr = PAIR[first + (c < cnt ? c : 0)]; const int q = (int)(pr & 255u), s = (int)(pr >> 8);
        bf16x8 qr[4];
#pragma unroll
        for (int d0 = 0; d0 < 4; ++d0) qr[d0] = *(const bf16x8*)(Qb + (size_t)q * QP + d0 * 16 + hi * 8);
        FState st; st.m = NEG; st.l = 0.f;
#pragma unroll
        for (int r = 0; r < 16; ++r) { st.o0[r] = 0.f; st.o1[r] = 0.f; }
        const bf16* kfb = Kf + (size_t)(n * 8) * 4 * 64 * 8; const bf16* vfb = Vf + (size_t)(n * 8) * 4 * 64 * 8;
        if (n == j - 1) flash_block<true>(st, qr, kfb, vfb, 4, 0.f, LUT, (j * MOBA + q) - n * MOBA + 256 - 8 * hi);
        else flash_block<false>(st, qr, kfb, vfb, 4, cb31, LUT, 0);
        const float lt = xhalf_sum(st.l), il = 1.0f / lt;
        if (c < cnt) {
            LAS unsigned char* so = lds + A_SO + (s * 256 + q) * SO_ROW;
#pragma unroll
            for (int a = 0; a < 4; ++a) {
                v2u w0; w0.x = cvtpk(st.o0[4 * a] * il, st.o0[4 * a + 1] * il); w0.y = cvtpk(st.o0[4 * a + 2] * il, st.o0[4 * a + 3] * il);
                v2u w1; w1.x = cvtpk(st.o1[4 * a] * il, st.o1[4 * a + 1] * il); w1.y = cvtpk(st.o1[4 * a + 2] * il, st.o1[4 * a + 3] * il);
                *(LAS v2u*)(so + (8 * a + 4 * hi) * 2) = w0; *(LAS v2u*)(so + (32 + 8 * a + 4 * hi) * 2) = w1; }
            if (hi == 0) LSE[s * 256 + q] = st.m + __builtin_amdgcn_logf(lt);
        }
    }
    __syncthreads();
    {
        FState st; st.m = NEG; st.l = 0.f;
#pragma unroll
        for (int r = 0; r < 16; ++r) { st.o0[r] = 0.f; st.o1[r] = 0.f; }
        flash_block<true>(st, qo, Kf + (size_t)(j * 8) * 4 * 64 * 8, Vf + (size_t)(j * 8) * 4 * 64 * 8, (wave >> 1) + 1, 0.f, LUT, q_own + 256 - 8 * hi);
        const float lt = xhalf_sum(st.l); const float lse_own = st.m + __builtin_amdgcn_logf(lt);
        float ls0 = NEG, ls1 = NEG, ls2 = NEG;
        if (nvalid > 0) ls0 = LSE[q_own]; if (nvalid > 1) ls1 = LSE[256 + q_own]; if (nvalid > 2) ls2 = LSE[512 + q_own];
        const float Mx = fmaxf(fmaxf(lse_own, ls0), fmaxf(ls1, ls2));
        const float w0 = __builtin_amdgcn_exp2f(ls0 - Mx), w1 = __builtin_amdgcn_exp2f(ls1 - Mx), w2 = __builtin_amdgcn_exp2f(ls2 - Mx), wo = __builtin_amdgcn_exp2f(st.m - Mx);
        const float inv = 1.0f / (wo * lt + w0 + w1 + w2);
        bf16* op = P.ATT + (row0 + (size_t)j * MOBA + q_own) * AW + h * HD;
#pragma unroll
        for (int a = 0; a < 4; ++a)
#pragma unroll
            for (int db = 0; db < 2; ++db) {
                const int d = 32 * db + 8 * a + 4 * hi; float v[4];
#pragma unroll
                for (int i = 0; i < 4; ++i) v[i] = (db ? st.o1[4 * a + i] : st.o0[4 * a + i]) * wo;
                if (nvalid > 0) { const v2u t = *(const LAS v2u*)(lds + A_SO + (0 * 256 + q_own) * SO_ROW + d * 2); v[0] += w0 * bflo(t.x); v[1] += w0 * bfhi(t.x); v[2] += w0 * bflo(t.y); v[3] += w0 * bfhi(t.y); }
                if (nvalid > 1) { const v2u t = *(const LAS v2u*)(lds + A_SO + (1 * 256 + q_own) * SO_ROW + d * 2); v[0] += w1 * bflo(t.x); v[1] += w1 * bfhi(t.x); v[2] += w1 * bflo(t.y); v[3] += w1 * bfhi(t.y); }
                if (nvalid > 2) { const v2u t = *(const LAS v2u*)(lds + A_SO + (2 * 256 + q_own) * SO_ROW + d * 2); v[0] += w2 * bflo(t.x); v[1] += w2 * bfhi(t.x); v[2] += w2 * bflo(t.y); v[3] += w2 * bfhi(t.y); }
                v2u o; o.x = cvtpk(v[0] * inv, v[1] * inv); o.y = cvtpk(v[2] * inv, v[3] * inv);
                *(v2u*)(op + d) = o; }
    }
    __syncthreads();
}
__device__ __forceinline__ void attn_phase(const Ptrs& P, LAS unsigned char* lds, int vcu, int G, int tid, int wave, int lane) {
    for (int u = vcu; u < BATCH * NH * NBLK; u += G) {
        const int bh = (u & 255) >> 4, j = (u < 256) ? 31 - (u & 15) : (u & 15);
        attn_unit(P, lds, bh >> 3, bh & 7, j, tid, wave, lane);
    }
}
#undef MOBA_MFMA
}

struct Args { const float* in[21]; float* out; unsigned char* ws; int ph_lo, ph_hi; };
__global__ void __launch_bounds__(NWAVES * 64, 2) mk_fwd(Args args) {
    __shared__ __attribute__((aligned(16))) unsigned char lds_raw[LDS_BYTES];
    LAS unsigned char* lds = (LAS unsigned char*)lds_raw;
    volatile LAS unsigned* MISC = (volatile LAS unsigned*)(lds + MISC_OFF);
    const int wave = __builtin_amdgcn_readfirstlane((int)threadIdx.x >> 6);
#define LANE_TID const int lane = mk_lane_now(), tid = wave * 64 + lane; (void)tid; (void)lane
    const int G = gridDim.x; const int bx = blockIdx.x; const int vcu = (G % 8 == 0) ? (bx % 8) * (G / 8) + bx / 8 : bx;
    const int gw = vcu * NWAVES + wave, NGW = G * NWAVES;
    Ptrs P; unsigned char* ws = args.ws;
    P.x = args.in[0]; P.p = args.in[1]; P.relb = args.in[2]; P.g_mix = args.in[3]; P.w_in = args.in[4]; P.pool_w = args.in[5]; P.pool_scale = args.in[6]; P.w_oa = args.in[7];
    P.w_op = args.in[8]; P.w_out = args.in[9]; P.g_ffn = args.in[10]; P.rw = args.in[11]; P.rb = args.in[12]; P.w_gu = args.in[13]; P.b_gu = args.in[14]; P.w_d = args.in[15];
    P.b_d = args.in[16]; P.g_ple = args.in[17]; P.w_pg = args.in[18]; P.w_pp = args.in[19]; P.g_fin = args.in[20];
    P.out = args.out; P.ws = ws; P.ctl = (gu32*)(ws + WS_CTL);
    P.WinT = (bf16*)(ws + WS_WIN); P.WaT = (bf16*)(ws + WS_WA); P.WcT = (bf16*)(ws + WS_WC); P.WoutT = (bf16*)(ws + WS_WOUT); P.WpgT = (bf16*)(ws + WS_WPG); P.WppT = (bf16*)(ws + WS_WPP);
    P.WguT = (bf16*)(ws + WS_WGU); P.WdT = (bf16*)(ws + WS_WD); P.XB = (bf16*)(ws + WS_XB); P.PB = (bf16*)(ws + WS_PB); P.QKVU = (bf16*)(ws + WS_QKVU); P.GATES = (bf16*)(ws + WS_GATES);
    P.PIN = (bf16*)(ws + WS_PIN); P.ATT = (bf16*)(ws + WS_ATT); P.TMP = (bf16*)(ws + WS_TMP); P.MERGED = (bf16*)(ws + WS_MERGED); P.X1N = (bf16*)(ws + WS_X1N); P.XG = (bf16*)(ws + WS_XG);
    P.KF = (bf16*)(ws + WS_XG); P.VF = (bf16*)(ws + WS_XG + 16 * MiB); P.ATT2 = (bf16*)(ws + WS_TMP); P.H = (bf16*)(ws + WS_H); P.Y = (bf16*)(ws + WS_Y); P.X2N = (bf16*)(ws + WS_X2N); P.PRJ = (bf16*)(ws + WS_PRJ);
    P.Wgu8 = ws + WS_WGU; P.Wd8 = ws + WS_WD; P.X1N8 = ws + WS_X1N; P.XG8 = ws + WS_XG; P.H8 = ws + WS_H;
    P.RSTD0 = (float*)(ws + WS_RSTD0); P.KMEAN = (float*)(ws + WS_KMEAN); P.TOPW = (float*)(ws + WS_TOPW); P.ROWW = (float*)(ws + WS_ROWW); P.TOPI = (int*)(ws + WS_TOPI); P.INV = (int*)(ws + WS_INV);

    { LANE_TID; for (int u = tid; u < (LDS_BYTES - RING_BYTES) / 4; u += NWAVES * 64) ((LAS unsigned*)(lds + RING_BYTES))[u] = 0u; }
    __syncthreads();
    XcdBarrier bar; bar.bar = (unsigned*)(P.ctl + CW_BAR); bar.x = 0; bar.st = nullptr;
    if (MK_N_LAUNCHES == 1) bar = xcd_barrier_post((unsigned*)(P.ctl + CW_BAR), MISC + 8);
    const int lo = args.ph_lo, hi = args.ph_hi;
#define IN(k) (lo <= (k) && (k) < hi)
#define SEAM(k) do { if (IN(k) && IN((k) + 1)) xcd_barrier(bar); } while (0)

    if (IN(0)) { LANE_TID; p0_prologue(P, lds, gw, NGW, wave, lane); }
#if MK_DUP_MASK & (1 << 0)
    if (IN(0)) { LANE_TID; p0_prologue(P, lds, gw, NGW, wave, lane); }
#endif
 SEAM(0);
    if (IN(1)) { pg8::Gemm g{P.XB, P.WinT, M, INC, D, wave}; pg8::StaticOrder S; S.init(M, INC, G, bx);
        mk::EpiInProj E{P.QKVU, P.GATES, P.RSTD0}; pg8::gemm_phase<mk::EpiInProj, pg8::StaticOrder, true, true>(lds, g, S, E); }
#if MK_DUP_MASK & (1 << 1)
    if (IN(1)) { pg8::Gemm g{P.XB, P.WinT, M, INC, D, wave}; pg8::StaticOrder S; S.init(M, INC, G, bx);
        mk::EpiInProj E{P.QKVU, P.GATES, P.RSTD0}; pg8::gemm_phase<mk::EpiInProj, pg8::StaticOrder, true, true>(lds, g, S, E); }
#endif
 SEAM(1);
    if (IN(2)) { LANE_TID; p2_kmean_pin(P, gw, NGW, lane); }
#if MK_DUP_MASK & (1 << 2)
    if (IN(2)) { LANE_TID; p2_kmean_pin(P, gw, NGW, lane); }
#endif
 SEAM(2);
    if (IN(3)) { LANE_TID;
#if MK_ATTN_SIMPLE
        p3_attn_simple(P, P.ATT, gw, NGW, lane);
#else
        moba::attn_phase(P, lds, vcu, G, tid, wave, lane);
#endif
    }
#if MK_DUP_MASK & (1 << 3)
    if (IN(3)) { LANE_TID;
#if MK_ATTN_SIMPLE
        p3_attn_simple(P, P.ATT, gw, NGW, lane);
#else
        moba::attn_phase(P, lds, vcu, G, tid, wave, lane);
#endif
    }
#endif
 SEAM(3);
    if (IN(4)) {
        { pg8::Gemm g{P.ATT, P.WaT, M, D, AW, wave}; pg8::StaticOrder S; S.init(M, D, G, bx);
          mk::EpiGateMul<false> E{P.GATES, 0, nullptr, P.TMP}; pg8::gemm_phase<mk::EpiGateMul<false>, pg8::StaticOrder, true, true>(lds, g, S, E); }
        VM_WAIT(); __syncthreads();
        { pg8::Gemm g{P.PIN, P.WcT, M, D, PW, wave}; pg8::StaticOrder S; S.init(M, D, G, bx);
          mk::EpiGateMul<true> E{P.GATES, D, P.TMP, P.MERGED}; pg8::gemm_phase<mk::EpiGateMul<true>, pg8::StaticOrder, true, true>(lds, g, S, E); }
    }
#if MK_DUP_MASK & (1 << 4)
    if (IN(4)) {
        { pg8::Gemm g{P.ATT, P.WaT, M, D, AW, wave}; pg8::StaticOrder S; S.init(M, D, G, bx);
          mk::EpiGateMul<false> E{P.GATES, 0, nullptr, P.TMP}; pg8::gemm_phase<mk::EpiGateMul<false>, pg8::StaticOrder, true, true>(lds, g, S, E); }
        VM_WAIT(); __syncthreads();
        { pg8::Gemm g{P.PIN, P.WcT, M, D, PW, wave}; pg8::StaticOrder S; S.init(M, D, G, bx);
          mk::EpiGateMul<true> E{P.GATES, D, P.TMP, P.MERGED}; pg8::gemm_phase<mk::EpiGateMul<true>, pg8::StaticOrder, true, true>(lds, g, S, E); }
    }
#endif
 SEAM(4);
    if (IN(5)) { pg8::Gemm g{P.MERGED, P.WoutT, M, D, D, wave}; pg8::StaticOrder S; S.init(M, D, G, bx);
        mk::EpiResF32 E{P.x, P.out}; pg8::gemm_phase<mk::EpiResF32, pg8::StaticOrder, true, true>(lds, g, S, E); }
#if MK_DUP_MASK & (1 << 5)
    if (IN(5)) { pg8::Gemm g{P.MERGED, P.WoutT, M, D, D, wave}; pg8::StaticOrder S; S.init(M, D, G, bx);
        mk::EpiResF32 E{P.x, P.out}; pg8::gemm_phase<mk::EpiResF32, pg8::StaticOrder, true, true>(lds, g, S, E); }
#endif
 SEAM(5);
    if (IN(6)) { LANE_TID; p6_router(P, lds, G, tid, wave, lane); }
#if MK_DUP_MASK & (1 << 6)
    if (IN(6)) { LANE_TID; p6_router(P, lds, G, tid, wave, lane); }
#endif
 SEAM(6);
    if (IN(7)) { LANE_TID; p7_permute(P, lds, G, tid, wave, lane); }
#if MK_DUP_MASK & (1 << 7)
    if (IN(7)) { LANE_TID; p7_permute(P, lds, G, tid, wave, lane); }
#endif
 SEAM(7);
    if (IN(8)) { pg8::Gemm g{(const bf16*)P.XG8, (const bf16*)P.Wgu8, MAXROWS, NE * 2048, D / 2, wave}; mk::MoeOrder S; S.init(P.ctl + CW_TILES, 8, G, bx);
        mk::EpiGlu E{P.b_gu, P.H8}; pg8::gemm_phase<mk::EpiGlu, mk::MoeOrder, true, true, true>(lds, g, S, E); }
#if MK_DUP_MASK & (1 << 8)
    if (IN(8)) { pg8::Gemm g{(const bf16*)P.XG8, (const bf16*)P.Wgu8, MAXROWS, NE * 2048, D / 2, wave}; mk::MoeOrder S; S.init(P.ctl + CW_TILES, 8, G, bx);
        mk::EpiGlu E{P.b_gu, P.H8}; pg8::gemm_phase<mk::EpiGlu, mk::MoeOrder, true, true, true>(lds, g, S, E); }
#endif
 SEAM(8);
    if (IN(9)) { pg8::Gemm g{(const bf16*)P.H8, (const bf16*)P.Wd8, MAXROWS, NE * D, FF / 2, wave}; mk::MoeOrder S; S.init(P.ctl + CW_TILES, 4, G, bx);
        mk::EpiDown E{P.b_d, P.ROWW, P.Y}; pg8::gemm_phase<mk::EpiDown, mk::MoeOrder, true, true, true>(lds, g, S, E); }
#if MK_DUP_MASK & (1 << 9)
    if (IN(9)) { pg8::Gemm g{(const bf16*)P.H8, (const bf16*)P.Wd8, MAXROWS, NE * D, FF / 2, wave}; mk::MoeOrder S; S.init(P.ctl + CW_TILES, 4, G, bx);
        mk::EpiDown E{P.b_d, P.ROWW, P.Y}; pg8::gemm_phase<mk::EpiDown, mk::MoeOrder, true, true, true>(lds, g, S, E); }
#endif
 SEAM(9);
    if (IN(10)) { LANE_TID; p10_combine(P, gw, NGW, lane); }
#if MK_DUP_MASK & (1 << 10)
    if (IN(10)) { LANE_TID; p10_combine(P, gw, NGW, lane); }
#endif
 SEAM(10);
    if (IN(11)) {
        { pg8::Gemm g{P.PB, P.WppT, M, D, PLE, wave}; pg8::StaticOrder S; S.init(M, D, G, bx);
          mk::EpiBf E{P.PRJ}; pg8::gemm_phase<mk::EpiBf, pg8::StaticOrder, true, true>(lds, g, S, E); }
        VM_WAIT(); __syncthreads();
        { pg8::Gemm g{P.X2N, P.WpgT, M, D, D, wave}; pg8::StaticOrder S; S.init(M, D, G, bx);
          mk::EpiPle E{P.out, P.PRJ}; pg8::gemm_phase<mk::EpiPle, pg8::StaticOrder, true, true>(lds, g, S, E); }
    }
#if MK_DUP_MASK & (1 << 11)
    if (IN(11)) {
        { pg8::Gemm g{P.PB, P.WppT, M, D, PLE, wave}; pg8::StaticOrder S; S.init(M, D, G, bx);
          mk::EpiBf E{P.PRJ}; pg8::gemm_phase<mk::EpiBf, pg8::StaticOrder, true, true>(lds, g, S, E); }
        VM_WAIT(); __syncthreads();
        { pg8::Gemm g{P.X2N, P.WpgT, M, D, D, wave}; pg8::StaticOrder S; S.init(M, D, G, bx);
          mk::EpiPle E{P.out, P.PRJ}; pg8::gemm_phase<mk::EpiPle, pg8::StaticOrder, true, true>(lds, g, S, E); }
    }
#endif
 SEAM(11);
    if (IN(12)) { LANE_TID; p12_final(P, gw, NGW, lane); }
#if MK_DUP_MASK & (1 << 12)
    if (IN(12)) { LANE_TID; p12_final(P, gw, NGW, lane); }
#endif
#undef IN
#undef SEAM
}

extern "C" void kernel_launch(void* const* d_in, const int* in_sizes, int n_in, void* d_out, int out_size, void* d_ws, size_t ws_size, hipStream_t stream) {
    static int grid = 0;
    if (grid == 0) {
        if (n_in != 21 || in_sizes[0] != M * D || out_size != M * D || ws_size < WS_END) { fprintf(stderr, "kernel_launch: unexpected shapes (n_in %d, in0 %d, out %d, ws %zu)\n", n_in, n_in > 0 ? in_sizes[0] : -1, out_size, ws_size); grid = -1; return; }
        int dev = 0, cus = 0;
        if (hipGetDevice(&dev) != hipSuccess || hipDeviceGetAttribute(&cus, hipDeviceAttributeMultiprocessorCount, dev) != hipSuccess) { grid = -1; return; }
        grid = cus;
    }
    if (grid < 0) return;
    (void)hipMemsetAsync((char*)d_ws + WS_CTL, 0, CTL_ZERO_BYTES, stream);
    Args a{};
    for (int i = 0; i < 21; ++i) a.in[i] = (const float*)d_in[i];
    a.out = (float*)d_out; a.ws = (unsigned char*)d_ws;
    if (MK_N_LAUNCHES == 1) { a.ph_lo = 0; a.ph_hi = NPH; hipLaunchKernelGGL(mk_fwd, dim3(grid), dim3(NWAVES * 64), 0, stream, a); }
    else for (int k = 0; k < NPH; ++k) { a.ph_lo = k; a.ph_hi = k + 1; hipLaunchKernelGGL(mk_fwd, dim3(grid), dim3(NWAVES * 64), 0, stream, a); }
}
```
